# Optimizing an MI355X kernel written in HIP

```python
import math
import numpy as np
import jax
import jax.numpy as jnp
from jax import lax

D_MODEL = 1024
BATCH = 32
SEQ = 256
DEPTH = 4
DEC_BATCH = 2
DEC_SEQ = 4096
PAST_LEN = 512

GRID_W = 64
DA_HEADS = 4
DA_QK = 64
DA_V = 2 * DA_QK
ML_HEADS = 4
ML_DIM = 128
ML_CHUNK = 64
ML_FORGET_BIAS = 3.0
NA_HEADS = 8
NA_DIM = 64
NA_WIN_ROWS = 8
NA_WIN_COLS = 16
N_BRANCH = 3
D_FF = 4 * D_MODEL
Q_BLOCK = 128
ROPE_BASE = 10000.0
EPS = 1e-6
DA_W = DA_HEADS * DA_V
ML_W = ML_HEADS * ML_DIM
NA_W = NA_HEADS * NA_DIM
SPLIT_SIZES = (
    DA_HEADS * 2 * DA_QK,
    DA_HEADS * 2 * DA_QK,
    DA_W,
    ML_W,
    ML_W,
    ML_W,
    ML_W,
    2 * 2 * ML_HEADS,
    NA_W,
    NA_W,
    NA_W,
    N_BRANCH * D_MODEL,
)
N_PROJ = sum(SPLIT_SIZES)
ML_GATE_OFF = sum(SPLIT_SIZES[:7])

kernel_name = 'hybrid_diffattn_mlstm_natten_prefix_step'


def rmsnorm(x, g):
    xf = x.astype(jnp.float32)
    y = xf * lax.rsqrt(jnp.mean(xf * xf, axis=-1, keepdims=True) + EPS)
    return (y * g.astype(jnp.float32)).astype(x.dtype)


def rope_1d(x, pos):
    d = x.shape[-1]
    freqs = ROPE_BASE ** (-jnp.arange(0, d, 2, dtype=jnp.float32) / d)
    ang = pos[:, None] * freqs[None, :]
    cos = jnp.cos(ang)[None, :, None, :]
    sin = jnp.sin(ang)[None, :, None, :]
    xf = x.astype(jnp.float32)
    x1, x2 = xf[..., : d // 2], xf[..., d // 2:]
    return jnp.concatenate([x1 * cos - x2 * sin, x1 * sin + x2 * cos], axis=-1).astype(x.dtype)


def rope_2d(x, rows, cols):
    half = x.shape[-1] // 2
    return jnp.concatenate([rope_1d(x[..., :half], rows), rope_1d(x[..., half:], cols)], axis=-1)


def over_query_blocks(fn, *qs):
    b, t = qs[0].shape[:2]
    nb = t // Q_BLOCK
    blocks = tuple(jnp.moveaxis(q.reshape((b, nb, Q_BLOCK) + q.shape[2:]), 1, 0) for q in qs)
    out = lax.map(lambda blk: fn(*blk), blocks)
    out = jnp.moveaxis(out, 0, 1)
    return out.reshape((b, t) + out.shape[3:])


def softmax_attention(q, k, v):
    scale = q.shape[-1] ** -0.5

    def block(qb):
        s = jnp.einsum('bqhd,bkhd->bhqk', qb, k).astype(jnp.float32) * scale
        p = jax.nn.softmax(s, axis=-1)
        return jnp.einsum('bhqk,bkhe->bqhe', p.astype(v.dtype), v)

    return over_query_blocks(block, q)


def diff_attention(q1, q2, k1, k2, v, lam):
    scale = q1.shape[-1] ** -0.5

    def block(q1b, q2b):
        p1 = jax.nn.softmax(jnp.einsum('bqhd,bkhd->bhqk', q1b, k1).astype(jnp.float32) * scale, axis=-1)
        p2 = jax.nn.softmax(jnp.einsum('bqhd,bkhd->bhqk', q2b, k2).astype(jnp.float32) * scale, axis=-1)
        p = p1 - lam * p2
        return jnp.einsum('bhqk,bkhe->bqhe', p.astype(v.dtype), v)

    return over_query_blocks(block, q1, q2)


def neighbourhood_attention(q, k, v, k_ctx, v_ctx, rpb):
    b, t, h, d = q.shape
    rows = t // GRID_W
    wr = min(NA_WIN_ROWS, rows)
    scale = d ** -0.5
    qg = q.reshape(b, rows, GRID_W, h, d)
    kg = k.reshape(b, rows, GRID_W, h, d)
    vg = v.reshape(b, rows, GRID_W, h, d)
    r = jnp.arange(rows)
    row_idx = jnp.clip(r - wr // 2, 0, rows - wr)[:, None] + jnp.arange(wr)[None, :]
    k_rows = kg[:, row_idx]
    v_rows = vg[:, row_idx]
    s_loc = jnp.einsum('brchd,brijhd->brhcij', qg, k_rows).astype(jnp.float32) * scale
    c = jnp.arange(GRID_W)
    col_start = jnp.clip(c - NA_WIN_COLS // 2, 0, GRID_W - NA_WIN_COLS)
    col_ok = (c[None, :] >= col_start[:, None]) & (c[None, :] < col_start[:, None] + NA_WIN_COLS)
    dr = row_idx - r[:, None] + (NA_WIN_ROWS - 1)
    dc = jnp.clip(c[None, :] - c[:, None] + (NA_WIN_COLS - 1), 0, 2 * NA_WIN_COLS - 2)
    bias = rpb[:, dr[:, None, :, None], dc[None, :, None, :]]
    bias = jnp.moveaxis(bias, 0, 1).astype(jnp.float32)
    s_loc = jnp.where(col_ok[:, None, :], s_loc + bias, -jnp.inf)
    s_ctx = jnp.einsum('brchd,bphd->brhcp', qg, k_ctx).astype(jnp.float32) * scale
    n_loc = wr * GRID_W
    s = jnp.concatenate([s_loc.reshape(b, rows, h, GRID_W, n_loc), s_ctx], axis=-1)
    p = jax.nn.softmax(s, axis=-1)
    p_loc = p[..., :n_loc].reshape(b, rows, h, GRID_W, wr, GRID_W).astype(v.dtype)
    p_ctx = p[..., n_loc:].astype(v.dtype)
    out = (jnp.einsum('brhcij,brijhd->brchd', p_loc, v_rows)
           + jnp.einsum('brhcp,bphd->brchd', p_ctx, v_ctx))
    return out.reshape(b, t, h, d)


def mlstm_chunked(q, k, v, ig, lf, c0, n0, m0):
    b, t, h, d = q.shape
    f32 = jnp.float32
    L = ML_CHUNK
    nc = t // L
    k = k.astype(f32) * (d ** -0.5)

    def to_chunks(a):
        a = a.astype(f32).reshape((b, nc, L) + a.shape[2:])
        return jnp.moveaxis(jnp.moveaxis(a, 1, 0), 2, 3)

    causal = jnp.tril(jnp.ones((L, L), dtype=bool))

    def step(carry, inp):
        cm, nm, mm = carry
        qc, kc, vc, ic, fc = inp
        bcum = jnp.cumsum(fc, axis=-1)
        logd = bcum[..., :, None] - bcum[..., None, :] + ic[..., None, :]
        logd = jnp.where(causal, logd, -jnp.inf)
        m_t = jnp.maximum(bcum + mm[..., None], jnp.max(logd, axis=-1))
        inter = jnp.exp(bcum + mm[..., None] - m_t)
        sc = jnp.einsum('bhtd,bhsd->bhts', qc, kc) * jnp.exp(logd - m_t[..., None])
        num = inter[..., None] * jnp.einsum('bhtd,bhde->bhte', qc, cm) + jnp.einsum('bhts,bhse->bhte', sc, vc)
        den = inter * jnp.einsum('bhtd,bhd->bht', qc, nm) + jnp.sum(sc, axis=-1)
        hc = num / jnp.maximum(jnp.abs(den), jnp.exp(-m_t))[..., None]
        m_new = m_t[..., -1]
        w = jnp.exp(bcum[..., -1:] - bcum + ic - m_new[..., None])
        decay = jnp.exp(bcum[..., -1] + mm - m_new)
        c_new = decay[..., None, None] * cm + jnp.einsum('bhs,bhsd,bhse->bhde', w, kc, vc)
        n_new = decay[..., None] * nm + jnp.einsum('bhs,bhsd->bhd', w, kc)
        return (c_new, n_new, m_new), hc

    init = (c0.astype(f32), n0.astype(f32), m0.astype(f32))
    final, hs = lax.scan(step, init, tuple(to_chunks(a) for a in (q, k, v, ig, lf)))
    hs = jnp.moveaxis(jnp.moveaxis(hs, 3, 2), 0, 1).reshape(b, t, h, d)
    return hs, final


def mlstm_bidir(q, k, v, gates, c0, n0, m0):
    hs, cs, ns, ms = [], [], [], []
    for dr in range(2):
        ig = gates[:, :, dr, 0]
        lf = jax.nn.log_sigmoid(gates[:, :, dr, 1].astype(jnp.float32))
        seq = (q, k, v, ig, lf)
        if dr == 1:
            seq = tuple(jnp.flip(a, axis=1) for a in seq)
        hd, (cf, nf, mf) = mlstm_chunked(*seq, c0[:, dr], n0[:, dr], m0[:, dr])
        if dr == 1:
            hd = jnp.flip(hd, axis=1)
        hs.append(hd)
        cs.append(cf)
        ns.append(nf)
        ms.append(mf)
    return hs[0] + hs[1], jnp.stack(cs, axis=1), jnp.stack(ns, axis=1), jnp.stack(ms, axis=1)


def layer(x, mod, lp, lam_init, ctx):
    b, t, _ = x.shape
    f32 = jnp.float32
    is_context = ctx is None
    sh1, sc1, g1, sh2, sc2, g2 = jnp.split(mod, 6, axis=-1)
    h = rmsnorm(x, lp['norm1']) * (1 + sc1) + sh1
    proj = h @ lp['w_in'] + lp['b_in']
    (da_q, da_k, da_v, ml_q, ml_k, ml_v, ml_o, ml_g,
     na_q, na_k, na_v, merge) = jnp.split(proj, np.cumsum(SPLIT_SIZES)[:-1].tolist(), axis=-1)

    dq = da_q.reshape(b, t, 2 * DA_HEADS, DA_QK)
    dk = da_k.reshape(b, t, 2 * DA_HEADS, DA_QK)
    dv = da_v.reshape(b, t, DA_HEADS, DA_V)
    if is_context:
        k_all = dk.reshape(b, t, DA_HEADS, 2 * DA_QK)
        v_all = dv
    else:
        pos = jnp.arange(t)
        rows = (pos // GRID_W).astype(f32)
        cols = (pos % GRID_W).astype(f32)
        dq = rope_2d(dq, rows, cols)
        dk = rope_2d(dk, rows, cols)
        k_all = jnp.concatenate([dk.reshape(b, t, DA_HEADS, 2 * DA_QK), ctx[0]], axis=1)
        v_all = jnp.concatenate([dv, ctx[1]], axis=1)
    q4 = dq.reshape(b, t, DA_HEADS, 2, DA_QK)
    k4 = k_all.reshape(b, -1, DA_HEADS, 2, DA_QK)
    lv = lp['da_lam'].astype(f32)
    lam = jnp.exp(jnp.sum(lv[0] * lv[1])) - jnp.exp(jnp.sum(lv[2] * lv[3])) + lam_init
    o_da = diff_attention(q4[..., 0, :], q4[..., 1, :], k4[..., 0, :], k4[..., 1, :], v_all, lam)
    o_da = (rmsnorm(o_da, lp['da_subln']) * (1.0 - lam_init)).reshape(b, t, DA_W)

    mq = ml_q.reshape(b, t, ML_HEADS, ML_DIM)
    mk = ml_k.reshape(b, t, ML_HEADS, ML_DIM)
    mv = ml_v.reshape(b, t, ML_HEADS, ML_DIM)
    gates = ml_g.reshape(b, t, 2, 2, ML_HEADS)
    if is_context:
        c0 = jnp.zeros((b, 2, ML_HEADS, ML_DIM, ML_DIM), f32)
        n0 = jnp.zeros((b, 2, ML_HEADS, ML_DIM), f32)
        m0 = jnp.zeros((b, 2, ML_HEADS), f32)
    else:
        c0, n0, m0 = ctx[4], ctx[5], ctx[6]
    h_ml, c_f, n_f, m_f = mlstm_bidir(mq, mk, mv, gates, c0, n0, m0)
    o_ml = (rmsnorm(h_ml, lp['ml_norm'].reshape(ML_HEADS, ML_DIM)).reshape(b, t, ML_W)
            * jax.nn.sigmoid(ml_o.astype(f32))).astype(x.dtype)

    nq = na_q.reshape(b, t, NA_HEADS, NA_DIM)
    nk = na_k.reshape(b, t, NA_HEADS, NA_DIM)
    nv = na_v.reshape(b, t, NA_HEADS, NA_DIM)
    if is_context:
        o_na = softmax_attention(nq, nk, nv)
    else:
        o_na = neighbourhood_attention(nq, nk, nv, ctx[2], ctx[3], lp['na_rpb'])
    o_na = o_na.reshape(b, t, NA_W)

    gate = jax.nn.sigmoid(merge.astype(f32)).astype(x.dtype).reshape(b, t, N_BRANCH, D_MODEL)
    merged = (gate[:, :, 0] * (o_da @ lp['w_up_da'])
              + gate[:, :, 1] * (o_ml @ lp['w_up_ml'])
              + gate[:, :, 2] * (o_na @ lp['w_up_na']))
    x = x + g1 * (merged @ lp['w_out'])

    h2 = rmsnorm(x, lp['norm2']) * (1 + sc2) + sh2
    u = jnp.square(jax.nn.relu(h2 @ lp['w_ff1'] + lp['b_ff1']))
    x = x + g2 * (u @ lp['w_ff2'] + lp['b_ff2'])
    new_ctx = (k_all, v_all, nk, nv, c_f, n_f, m_f) if is_context else None
    return x, new_ctx


def setup_inputs(seed: int = 0) -> dict:
    key = jax.random.key(seed)
    ks = jax.random.split(key, 40)
    f32 = jnp.float32

    def nrm(k, shape, s):
        return s * jax.random.normal(k, shape, f32)

    f_cols = ML_GATE_OFF + np.array([dr * 2 * ML_HEADS + ML_HEADS + hh for dr in range(2) for hh in range(ML_HEADS)])
    b_in = nrm(ks[15], (DEPTH, N_PROJ), 0.02).at[:, f_cols].add(ML_FORGET_BIAS)
    return {
        'x_prompt': nrm(ks[0], (BATCH, SEQ, D_MODEL), 1.0),
        'x_sample': nrm(ks[1], (DEC_BATCH, DEC_SEQ, D_MODEL), 1.0),
        'cache_da_k': nrm(ks[2], (DEC_BATCH, DEPTH, PAST_LEN, DA_HEADS, 2 * DA_QK), 1.0),
        'cache_da_v': nrm(ks[3], (DEC_BATCH, DEPTH, PAST_LEN, DA_HEADS, DA_V), 1.0),
        'cache_na_k': nrm(ks[4], (DEC_BATCH, DEPTH, PAST_LEN, NA_HEADS, NA_DIM), 1.0),
        'cache_na_v': nrm(ks[5], (DEC_BATCH, DEPTH, PAST_LEN, NA_HEADS, NA_DIM), 1.0),
        'state_ml_C': nrm(ks[6], (DEC_BATCH, DEPTH, 2, ML_HEADS, ML_DIM, ML_DIM), 0.1),
        'state_ml_n': nrm(ks[7], (DEC_BATCH, DEPTH, 2, ML_HEADS, ML_DIM), 0.1),
        'state_ml_m': nrm(ks[8], (DEC_BATCH, DEPTH, 2, ML_HEADS), 1.0),
        'c': nrm(ks[9], (DEC_BATCH, D_MODEL), 1.0),
        'c_ctx': nrm(ks[10], (D_MODEL,), 1.0),
        'w_mod': nrm(ks[11], (DEPTH, D_MODEL, 6 * D_MODEL), D_MODEL ** -0.5),
        'b_mod': nrm(ks[12], (DEPTH, 6 * D_MODEL), 0.02),
        'norm1': 1.0 + nrm(ks[13], (DEPTH, D_MODEL), 0.02),
        'w_in': nrm(ks[14], (DEPTH, D_MODEL, N_PROJ), D_MODEL ** -0.5),
        'b_in': b_in,
        'da_lam': nrm(ks[16], (DEPTH, 4, DA_QK), 0.1),
        'da_subln': 1.0 + nrm(ks[17], (DEPTH, DA_V), 0.02),
        'ml_norm': 1.0 + nrm(ks[18], (DEPTH, ML_W), 0.02),
        'na_rpb': nrm(ks[19], (DEPTH, NA_HEADS, 2 * NA_WIN_ROWS - 1, 2 * NA_WIN_COLS - 1), 0.02),
        'w_up_da': nrm(ks[20], (DEPTH, DA_W, D_MODEL), DA_W ** -0.5),
        'w_up_ml': nrm(ks[21], (DEPTH, ML_W, D_MODEL), ML_W ** -0.5),
        'w_up_na': nrm(ks[22], (DEPTH, NA_W, D_MODEL), NA_W ** -0.5),
        'w_out': nrm(ks[23], (DEPTH, D_MODEL, D_MODEL), D_MODEL ** -0.5),
        'norm2': 1.0 + nrm(ks[24], (DEPTH, D_MODEL), 0.02),
        'w_ff1': nrm(ks[25], (DEPTH, D_MODEL, D_FF), D_MODEL ** -0.5),
        'b_ff1': nrm(ks[26], (DEPTH, D_FF), 0.02),
        'w_ff2': nrm(ks[27], (DEPTH, D_FF, D_MODEL), D_FF ** -0.5),
        'b_ff2': nrm(ks[28], (DEPTH, D_MODEL), 0.02),
        'norm_f': 1.0 + nrm(ks[29], (D_MODEL,), 0.02),
    }


def reference(x_prompt, x_sample, cache_da_k, cache_da_v, cache_na_k, cache_na_v,
              state_ml_C, state_ml_n, state_ml_m, c, c_ctx, w_mod, b_mod, norm1, w_in, b_in,
              da_lam, da_subln, ml_norm, na_rpb, w_up_da, w_up_ml, w_up_na, w_out, norm2,
              w_ff1, b_ff1, w_ff2, b_ff2, norm_f):
    collected = [[] for _ in range(7)]
    xp, xs = x_prompt, x_sample
    for l in range(DEPTH):
        lp = {
            'norm1': norm1[l], 'w_in': w_in[l], 'b_in': b_in[l], 'da_lam': da_lam[l],
            'da_subln': da_subln[l], 'ml_norm': ml_norm[l], 'na_rpb': na_rpb[l],
            'w_up_da': w_up_da[l], 'w_up_ml': w_up_ml[l], 'w_up_na': w_up_na[l],
            'w_out': w_out[l], 'norm2': norm2[l], 'w_ff1': w_ff1[l], 'b_ff1': b_ff1[l],
            'w_ff2': w_ff2[l], 'b_ff2': b_ff2[l],
        }
        lam_init = 0.8 - 0.6 * math.exp(-0.3 * l)
        mod_ctx = (jax.nn.silu(c_ctx) @ w_mod[l] + b_mod[l])[None, None, :]
        mod_lat = (jax.nn.silu(c) @ w_mod[l] + b_mod[l])[:, None, :]
        xp, ctx_l = layer(xp, mod_ctx, lp, lam_init, None)
        cache_l = (cache_da_k[:, l], cache_da_v[:, l], cache_na_k[:, l], cache_na_v[:, l],
                   state_ml_C[:, l], state_ml_n[:, l], state_ml_m[:, l])
        xs, _ = layer(xs, mod_lat, lp, lam_init, cache_l)
        for lst, arr in zip(collected, ctx_l):
            lst.append(arr)
    y_prompt = rmsnorm(xp, norm_f)
    y_sample = rmsnorm(xs, norm_f)
    new_da_k = jnp.stack(collected[0], axis=1)
    new_da_v = jnp.stack(collected[1], axis=1)
    new_na_k = jnp.stack(collected[2], axis=1)
    new_na_v = jnp.stack(collected[3], axis=1)
    new_ml_C = jnp.stack(collected[4], axis=1)
    new_ml_n = jnp.stack(collected[5], axis=1)
    new_ml_m = jnp.stack(collected[6], axis=1)
    return (y_prompt, y_sample, new_da_k, new_da_v, new_na_k, new_na_v, new_ml_C, new_ml_n, new_ml_m)
```

```cpp
#include <hip/hip_runtime.h>
#include <hip/hip_cooperative_groups.h>
#include <stdint.h>
#include <cstdio>
namespace cg = cooperative_groups;

#ifndef LATMASK
#define LATMASK 7
#endif
#ifndef MK_ONE_LAUNCH
#define MK_ONE_LAUNCH 1
#endif

typedef unsigned short bf16_t;
typedef __attribute__((ext_vector_type(8))) short bf16x8;
typedef __attribute__((ext_vector_type(4))) short bf16x4;
typedef __attribute__((ext_vector_type(16))) float f32x16;
#define MFMA32(a, b, c) __builtin_amdgcn_mfma_f32_32x32x16_bf16((a), (b), (c), 0, 0, 0)
#define DI __device__ __forceinline__

#define MTOT 16384
#define MCTX 8192
#define LDP 6656
#define NPROJ 8208
#define NPAD 8320
#define NPHASE 46
#define QSCALE 0.18033688011112042f
#define KSCALE 0.08838834764831845f
#define LOG2E 1.4426950408889634f

#define OUT_YS     8388608
#define OUT_DAK   16777216
#define OUT_DAV   33554432
#define OUT_NAK   50331648
#define OUT_NAV   67108864
#define OUT_MLC   83886080
#define OUT_MLN  100663296
#define OUT_MLM  100794368

#define OFF_WT_IN   0ull
#define OFF_WT_UP   (OFF_WT_IN + 17039360ull)
#define OFF_WT_OUT  (OFF_WT_UP + 3145728ull)
#define OFF_WT_FF1  (OFF_WT_OUT + 2097152ull)
#define OFF_WT_FF2  (OFF_WT_FF1 + 8388608ull)
#define OFF_X       (OFF_WT_FF2 + 8388608ull)
#define OFF_HB      (OFF_X + 67108864ull)
#define OFF_PROJ    (OFF_HB + 33554432ull)
#define OFF_OCAT    (OFF_PROJ + 218103808ull)
#define OFF_VT_DA   (OFF_OCAT + 50331648ull)
#define OFF_VT_NA   (OFF_VT_DA + 16777216ull)
#define OFF_KT_ML   (OFF_VT_NA + 16777216ull)
#define OFF_VT_ML   (OFF_KT_ML + 16777216ull)
#define OFF_KC_DA   (OFF_VT_ML + 16777216ull)
#define OFF_VTC_DA  (OFF_KC_DA + 4194304ull)
#define OFF_KC_NA   (OFF_VTC_DA + 4194304ull)
#define OFF_VTC_NA  (OFF_KC_NA + 4194304ull)
#define OFF_GATES   (OFF_VTC_NA + 4194304ull)
#define OFF_MOD     (OFF_GATES + 1048576ull)
#define OFF_BINP    (OFF_MOD + 294912ull)
#define OFF_ROPE    (OFF_BINP + 133120ull)
#define OFF_LAM     (OFF_ROPE + 8192ull)
#define OFF_CTR     (OFF_LAM + 256ull)
#define OFF_BAR     (OFF_CTR + 256ull)
#define OFF_SC      (OFF_BAR + 16384ull)
#define OFF_DN      (OFF_SC + 8192ull)
#define OFF_DC      (OFF_DN + 524288ull)
#define WS_NEEDED   (OFF_DC + 33554432ull)

#define SMEM_BYTES 77824

struct Params {
  const float *x_prompt, *x_sample, *cache_da_k, *cache_da_v, *cache_na_k, *cache_na_v;
  const float *state_C, *state_n, *state_m, *c, *c_ctx, *w_mod, *b_mod, *norm1, *w_in, *b_in;
  const float *da_lam, *da_subln, *ml_norm, *na_rpb, *w_up_da, *w_up_ml, *w_up_na, *w_out, *norm2;
  const float *w_ff1, *b_ff1, *w_ff2, *b_ff2, *norm_f;
  float* out;
  char* ws;
};

typedef __bf16 bf2_t __attribute__((ext_vector_type(2)));
typedef float f2_t __attribute__((ext_vector_type(2)));
DI unsigned pack2(float a, float b) { f2_t v; v.x = a; v.y = b; return __builtin_bit_cast(unsigned, __builtin_convertvector(v, bf2_t)); }
DI bf16_t f2bf(float f) { return (bf16_t)(pack2(f, 0.f) & 0xffffu); }
DI float bf2f(bf16_t b) { return __uint_as_float(((unsigned)b) << 16); }
DI float bflo(unsigned u) { return __uint_as_float(u << 16); }
DI float bfhi(unsigned u) { return __uint_as_float(u & 0xffff0000u); }
DI float fexp2(float x) { return __builtin_amdgcn_exp2f(x); }
DI float fexp(float x) { return __builtin_amdgcn_exp2f(x * LOG2E); }
DI float frcp(float x) { return __builtin_amdgcn_rcpf(x); }
DI float flog1pexp(float a) { return __builtin_amdgcn_logf(1.f + fexp(-a)) * 0.6931471805599453f; }
DI float fsigmoid(float x) { return frcp(1.f + fexp(-x)); }
DI int otid() { int t = threadIdx.x; asm volatile("" : "+v"(t)); return t; }
DI unsigned xb_xcc_id() { return (unsigned)__builtin_amdgcn_s_getreg((3 << 11) | 20) & 0xFu; }
DI int crow(int r, int h) { return (r & 3) + 8 * (r >> 2) + 4 * h; }
DI float lam_init_of(int l) { return 0.8f - 0.6f * expf(-0.3f * (float)l); }
DI int seg_start(int seg) {
  switch (seg) {
    case 0: return 0;
    case 1: return 512;
    case 2: return 1536;
    case 3: return 2048;
    case 4: return 3072;
    case 5: return 3600;
    case 6: return 4112;
    case 13: return 1024;
    case 14: return 2560;
    case 15: return 4624;
    case 16: return 3584;
    default: return 5136 + (seg - 7) * 512;
  }
}
DI bf16x8 pack8(const f32x16& x, int s) {
  union { bf16x8 v; unsigned u[4]; } r;
  if (s == 0) { r.u[0] = pack2(x[0], x[1]); r.u[1] = pack2(x[2], x[3]); r.u[2] = pack2(x[4], x[5]); r.u[3] = pack2(x[6], x[7]); }
  else        { r.u[0] = pack2(x[8], x[9]); r.u[1] = pack2(x[10], x[11]); r.u[2] = pack2(x[12], x[13]); r.u[3] = pack2(x[14], x[15]); }
  return r.v;
}
DI f32x16 zero16() { f32x16 z; for (int i = 0; i < 16; ++i) z[i] = 0.f; return z; }
DI const float* xrow_in(const Params& p, int row) {
  return row < MCTX ? p.x_prompt + (size_t)row * 1024 : p.x_sample + (size_t)(row - MCTX) * 1024;
}
DI int mod_idx(int row) { return row < MCTX ? 0 : 1 + ((row - MCTX) >> 12); }
DI size_t tr_index(int row, int col) {
  if (row < MCTX) return ((size_t)((row >> 8) * 512 + col)) * 256 + (row & 255);
  int r2 = row - MCTX;
  return 4194304ull + ((size_t)((r2 >> 12) * 512 + col)) * 4096 + (r2 & 4095);
}

DI size_t blkA(int row, int k, int kblocks) { return ((size_t)((row >> 8) * kblocks + (k >> 5))) * 8192 + (row & 255) * 32 + (k & 31); }
DI size_t blkB(int n, int k, int kblocks) { return ((size_t)((n >> 7) * kblocks + (k >> 5))) * 4096 + (n & 127) * 32 + (k & 31); }

#define GS 72
DI void gemm_mainloop(const bf16_t* __restrict__ A, int lda, const bf16_t* __restrict__ B, int ldb, int K,
                      int m0, int n0, f32x16 (&acc)[2][2], char* smem_raw) {
  bf16_t* smem = (bf16_t*)smem_raw;
  const int tid = otid(), lane = tid & 63, wave = tid >> 6;
  const int wm = wave >> 1, wn = wave & 1, l31 = lane & 31, hh = lane >> 5;
  const bf16_t* ag = A + (size_t)(m0 + (tid >> 3)) * lda + (tid & 7) * 8;
  const bf16_t* bg = B + (size_t)(n0 + (tid >> 3)) * ldb + (tid & 7) * 8;
  const int soff = (tid >> 3) * GS + (tid & 7) * 8;
  uint4 ra0, ra1, ra2, ra3, rb0, rb1, rb2, rb3;
#define G_LD(K0_) do { \
    ra0 = *(const uint4*)(ag + (K0_)); ra1 = *(const uint4*)(ag + (size_t)32 * lda + (K0_)); \
    ra2 = *(const uint4*)(ag + (size_t)64 * lda + (K0_)); ra3 = *(const uint4*)(ag + (size_t)96 * lda + (K0_)); \
    rb0 = *(const uint4*)(bg + (K0_)); rb1 = *(const uint4*)(bg + (size_t)32 * ldb + (K0_)); \
    rb2 = *(const uint4*)(bg + (size_t)64 * ldb + (K0_)); rb3 = *(const uint4*)(bg + (size_t)96 * ldb + (K0_)); } while (0)
  G_LD(0);
  __syncthreads();
  const int nk = K >> 6;
#pragma unroll 1
  for (int kt = 0; kt < nk; ++kt) {
    bf16_t* sa = smem + (kt & 1) * (2 * 128 * GS);
    bf16_t* sb = sa + 128 * GS;
    *(uint4*)(sa + soff) = ra0; *(uint4*)(sa + soff + 32 * GS) = ra1; *(uint4*)(sa + soff + 64 * GS) = ra2; *(uint4*)(sa + soff + 96 * GS) = ra3;
    *(uint4*)(sb + soff) = rb0; *(uint4*)(sb + soff + 32 * GS) = rb1; *(uint4*)(sb + soff + 64 * GS) = rb2; *(uint4*)(sb + soff + 96 * GS) = rb3;
    __syncthreads();
    {
      const int k0 = min(kt + 1, nk - 1) << 6;
      G_LD(k0);
    }
    __builtin_amdgcn_sched_barrier(0);
#pragma unroll
    for (int s = 0; s < 4; ++s) {
      bf16x8 a0 = *(const bf16x8*)(sa + (wm * 64 + l31) * GS + s * 16 + hh * 8);
      bf16x8 a1 = *(const bf16x8*)(sa + (wm * 64 + 32 + l31) * GS + s * 16 + hh * 8);
      bf16x8 b0 = *(const bf16x8*)(sb + (wn * 64 + l31) * GS + s * 16 + hh * 8);
      bf16x8 b1 = *(const bf16x8*)(sb + (wn * 64 + 32 + l31) * GS + s * 16 + hh * 8);
      acc[0][0] = MFMA32(a0, b0, acc[0][0]);
      acc[0][1] = MFMA32(a0, b1, acc[0][1]);
      acc[1][0] = MFMA32(a1, b0, acc[1][0]);
      acc[1][1] = MFMA32(a1, b1, acc[1][1]);
    }
  }
  __syncthreads();
}

#define CS 132
DI void stage_acc(const f32x16 (&acc)[2][2], char* smem_raw) {
  float* cst = (float*)smem_raw;
  const int lane = otid() & 63, wave = otid() >> 6;
  const int wm = wave >> 1, wn = wave & 1, l31 = lane & 31, hh = lane >> 5;
#pragma unroll
  for (int i = 0; i < 2; ++i)
#pragma unroll
    for (int j = 0; j < 2; ++j)
#pragma unroll
      for (int r = 0; r < 16; ++r)
        cst[(wm * 64 + i * 32 + crow(r, hh)) * CS + wn * 64 + j * 32 + l31] = acc[i][j][r];
  __syncthreads();
}
DI void ld8(const float* p, float (&v)[8]) {
  const float4 a = *(const float4*)p, b = *(const float4*)(p + 4);
  v[0] = a.x; v[1] = a.y; v[2] = a.z; v[3] = a.w; v[4] = b.x; v[5] = b.y; v[6] = b.z; v[7] = b.w;
}
DI void st8(float* p, const float (&v)[8]) {
  *(float4*)p = make_float4(v[0], v[1], v[2], v[3]); *(float4*)(p + 4) = make_float4(v[4], v[5], v[6], v[7]);
}
DI uint4 pack8f(const float (&v)[8]) { return make_uint4(pack2(v[0], v[1]), pack2(v[2], v[3]), pack2(v[4], v[5]), pack2(v[6], v[7])); }

#define G2S 40
#define G2STAGE 15360
DI void gemm_mainloop256(const bf16_t* __restrict__ A, int lda, const bf16_t* __restrict__ B, int ldb, int K,
                         int m0, int n0, f32x16 (&acc)[4][2], char* smem_raw) {
  bf16_t* smem = (bf16_t*)smem_raw;
  const int tid = otid(), lane = tid & 63, wave = tid >> 6;
  const int wm = wave >> 1, wn = wave & 1, l31 = lane & 31, hh = lane >> 5;
  const int kblocks = K >> 5;
  const bf16_t* ag = A + (size_t)(m0 >> 8) * kblocks * 8192 + tid * 8;
  const bf16_t* bg = B + (size_t)(n0 >> 7) * kblocks * 4096 + tid * 8;
  (void)lda; (void)ldb;
  const int soff = (tid >> 2) * G2S + (tid & 3) * 8;
  uint4 ra0, ra1, ra2, ra3, rb0, rb1;
#define G2_LD(K0_) do { \
    const bf16_t* ap_ = ag + (size_t)((K0_) >> 5) * 8192; const bf16_t* bp_ = bg + (size_t)((K0_) >> 5) * 4096; \
    ra0 = *(const uint4*)(ap_); ra1 = *(const uint4*)(ap_ + 2048); ra2 = *(const uint4*)(ap_ + 4096); ra3 = *(const uint4*)(ap_ + 6144); \
    rb0 = *(const uint4*)(bp_); rb1 = *(const uint4*)(bp_ + 2048); } while (0)
  G2_LD(0);
  __syncthreads();
  const int nk = K >> 5;
#pragma unroll 1
  for (int kt = 0; kt < nk; ++kt) {
    bf16_t* sa = smem + (kt & 1) * G2STAGE;
    bf16_t* sb = sa + 256 * G2S;
    *(uint4*)(sa + soff) = ra0; *(uint4*)(sa + soff + 64 * G2S) = ra1; *(uint4*)(sa + soff + 128 * G2S) = ra2; *(uint4*)(sa + soff + 192 * G2S) = ra3;
    *(uint4*)(sb + soff) = rb0; *(uint4*)(sb + soff + 64 * G2S) = rb1;
    __syncthreads();
    {
      const int k0 = min(kt + 1, nk - 1) << 5;
      G2_LD(k0);
    }
    __builtin_amdgcn_sched_barrier(0);
    bf16x8 a[2][4], b[2][2];
#pragma unroll
    for (int s = 0; s < 2; ++s) {
#pragma unroll
      for (int i = 0; i < 4; ++i) a[s][i] = *(const bf16x8*)(sa + (wm * 128 + i * 32 + l31) * G2S + s * 16 + hh * 8);
#pragma unroll
      for (int j = 0; j < 2; ++j) b[s][j] = *(const bf16x8*)(sb + (wn * 64 + j * 32 + l31) * G2S + s * 16 + hh * 8);
    }
    __builtin_amdgcn_sched_barrier(0);
#pragma unroll
    for (int s = 0; s < 2; ++s)
#pragma unroll
      for (int i = 0; i < 4; ++i)
#pragma unroll
        for (int j = 0; j < 2; ++j) acc[i][j] = MFMA32(a[s][i], b[s][j], acc[i][j]);
  }
  __syncthreads();
}
template <int PS>
DI void stage_acc256(const f32x16 (&acc)[4][2], char* smem_raw) {
  float* cst = (float*)smem_raw;
  const int tid = otid(), lane = tid & 63, wave = tid >> 6;
  const int wm = wave >> 1, wn = wave & 1, l31 = lane & 31, hh = lane >> 5;
  __syncthreads();
#pragma unroll
  for (int i2 = 0; i2 < 2; ++i2)
#pragma unroll
    for (int j = 0; j < 2; ++j)
#pragma unroll
      for (int r = 0; r < 16; ++r)
        cst[(wm * 64 + i2 * 32 + crow(r, hh)) * CS + wn * 64 + j * 32 + l31] = acc[2 * PS + i2][j][r];
  __syncthreads();
}
DI int rowmap256(int rl, int ps) { return (rl >> 6) * 128 + ps * 64 + (rl & 63); }
#define GEMM256_TILE_LOOP(NT) \
  for (int u_ = blockIdx.x >> 3, xcd_ = blockIdx.x & 7, mt, nt; u_ < (((NT) + 7) >> 3) * 64; u_ += gridDim.x >> 3) \
    if ((mt = ((u_ & 63) >> 3) * 8 + xcd_, nt = (u_ >> 6) * 8 + (u_ & 7), nt < (NT)))

DI bool gemm_tile_coords(int u, int xcd, int NT, int& mt, int& nt) {
  const int NTG = (NT + 7) >> 3;
  const int q = u >> 6, r = u & 63;
  nt = (q % NTG) * 8 + (r & 7);
  const int mi = (q / NTG) * 8 + (r >> 3);
  mt = mi * 8 + xcd;
  return nt < NT && mi < 16;
}
#define GEMM_TILE_LOOP(NT) \
  for (int u_ = blockIdx.x >> 3, xcd_ = blockIdx.x & 7, mt, nt; u_ < 2 * (((NT) + 7) >> 3) * 64; u_ += gridDim.x >> 3) \
    if (gemm_tile_coords(u_, xcd_, (NT), mt, nt))

__device__ void phase_setup(const Params& p, char* smem_raw) {
  const int tid = otid();
  float* MOD = (float*)(p.ws + OFF_MOD);
  float* sil = (float*)smem_raw;
  float* red = sil + 3072;
  for (int it = blockIdx.x; it < 384; it += gridDim.x) {
    const int l = it / 96, ch = it % 96;
    __syncthreads();
    for (int i = tid; i < 3072; i += 256) {
      const int v = i >> 10, k = i & 1023;
      const float cv = (v == 0) ? p.c_ctx[k] : p.c[(v - 1) * 1024 + k];
      sil[i] = cv / (1.f + expf(-cv));
    }
    __syncthreads();
    const int kg = tid >> 6, cc = tid & 63;
    const float* w = p.w_mod + ((size_t)l * 1024 + kg * 256) * 6144 + ch * 64 + cc;
    float a0 = 0.f, a1 = 0.f, a2 = 0.f;
#pragma unroll 8
    for (int k = 0; k < 256; ++k) {
      const float wv = w[(size_t)k * 6144];
      a0 += sil[kg * 256 + k] * wv; a1 += sil[1024 + kg * 256 + k] * wv; a2 += sil[2048 + kg * 256 + k] * wv;
    }
    red[(kg * 3 + 0) * 64 + cc] = a0; red[(kg * 3 + 1) * 64 + cc] = a1; red[(kg * 3 + 2) * 64 + cc] = a2;
    __syncthreads();
    if (tid < 192) {
      const int v = tid >> 6, c2 = tid & 63;
      const float s = red[(0 * 3 + v) * 64 + c2] + red[(1 * 3 + v) * 64 + c2] + red[(2 * 3 + v) * 64 + c2] + red[(3 * 3 + v) * 64 + c2];
      MOD[(l * 3 + v) * 6144 + ch * 64 + c2] = s + p.b_mod[l * 6144 + ch * 64 + c2];
    }
  }
  const int gtid = blockIdx.x * 256 + tid, gsz = gridDim.x * 256;
  bf16_t* KC_DA = (bf16_t*)(p.ws + OFF_KC_DA); bf16_t* KC_NA = (bf16_t*)(p.ws + OFF_KC_NA);
  bf16_t* VTC_DA = (bf16_t*)(p.ws + OFF_VTC_DA); bf16_t* VTC_NA = (bf16_t*)(p.ws + OFF_VTC_NA);
  for (int i = gtid; i < 2097152; i += gsz) {
    KC_DA[i] = f2bf(p.cache_da_k[i]);
    KC_NA[i] = f2bf(p.cache_na_k[i]);
    {
      const int pp = i & 511, dv = (i >> 9) & 127, h = (i >> 16) & 3, bl = i >> 18;
      VTC_DA[i] = f2bf(p.cache_da_v[((size_t)bl * 512 + pp) * 512 + h * 128 + dv]);
    }
    {
      const int pp = i & 511, dv = (i >> 9) & 63, h = (i >> 15) & 7, bl = i >> 18;
      VTC_NA[i] = f2bf(p.cache_na_v[((size_t)bl * 512 + pp) * 512 + h * 64 + dv]);
    }
  }
  float* ROPE = (float*)(p.ws + OFF_ROPE);
  for (int i = gtid; i < 1024; i += gsz) {
    const int pos = i >> 4, fi = i & 15;
    const float freq = powf(10000.f, -(float)fi / 16.f);
    const float ang = (float)pos * freq;
    ROPE[i] = cosf(ang); ROPE[1024 + i] = sinf(ang);
  }
  float* BINP = (float*)(p.ws + OFF_BINP);
  for (int i = gtid; i < 4 * NPAD; i += gsz) {
    const int l = i / NPAD, n = i % NPAD, seg = n >> 9;
    const bool valid = seg < 16 || (n & 511) < 16;
    BINP[i] = valid ? p.b_in[l * NPROJ + seg_start(seg) + (n & 511)] : 0.f;
  }
  if (gtid < 4) {
    const float* lv = p.da_lam + gtid * 256;
    float s1 = 0.f, s2 = 0.f;
    for (int j = 0; j < 64; ++j) { s1 += lv[j] * lv[64 + j]; s2 += lv[128 + j] * lv[192 + j]; }
    ((float*)(p.ws + OFF_LAM))[gtid] = expf(s1) - expf(s2) + lam_init_of(gtid);
  }
  if (gtid < 64) ((int*)(p.ws + OFF_CTR))[gtid] = 0;
}

DI void transpose_tile(const float* __restrict__ src, int ldsrc, int srccol0, int nvalid, int k0, bf16_t* __restrict__ dst, int K, int n0, char* smem_raw, bool blocked) {
  float* tile = (float*)smem_raw;
  const int tid = otid();
  __syncthreads();
  {
    const int n = tid & 63, kq = tid >> 6;
    const bool ok = n < nvalid;
#pragma unroll 4
    for (int r = 0; r < 16; ++r) {
      const int k = r * 4 + kq;
      tile[k * 65 + n] = ok ? src[(size_t)(k0 + k) * ldsrc + srccol0 + n] : 0.f;
    }
  }
  __syncthreads();
  {
    const int n = tid >> 2, kq = (tid & 3) * 16;
    unsigned o[8];
#pragma unroll
    for (int i = 0; i < 8; ++i) o[i] = pack2(tile[(kq + 2 * i) * 65 + n], tile[(kq + 2 * i + 1) * 65 + n]);
    uint4* d = (uint4*)(dst + (blocked ? blkB(n0 + n, k0 + kq, K >> 5) : (size_t)(n0 + n) * K + k0 + kq));
    d[0] = make_uint4(o[0], o[1], o[2], o[3]);
    d[1] = make_uint4(o[4], o[5], o[6], o[7]);
  }
}

DI void norm_row(const Params& p, int l, int row, int which) {
  const int lane = otid() & 63;
  const float* X = (const float*)(p.ws + OFF_X);
  const float* x = (which == 0 && l == 0) ? xrow_in(p, row) : X + (size_t)row * 1024;
  float4 v[4];
  float ss = 0.f;
#pragma unroll
  for (int i = 0; i < 4; ++i) { v[i] = ((const float4*)x)[lane + i * 64]; ss += v[i].x * v[i].x + v[i].y * v[i].y + v[i].z * v[i].z + v[i].w * v[i].w; }
#pragma unroll
  for (int off = 32; off >= 1; off >>= 1) ss += __shfl_xor(ss, off);
  const float rstd = rsqrtf(ss * (1.f / 1024.f) + 1e-6f);
  if (which == 2) {
#pragma unroll
    for (int i = 0; i < 4; ++i) {
      const float4 g = ((const float4*)p.norm_f)[lane + i * 64];
      float4 o; o.x = v[i].x * rstd * g.x; o.y = v[i].y * rstd * g.y; o.z = v[i].z * rstd * g.z; o.w = v[i].w * rstd * g.w;
      ((float4*)(p.out + (size_t)row * 1024))[lane + i * 64] = o;
    }
  } else {
    const float* gp = (which == 0 ? p.norm1 : p.norm2) + l * 1024;
    const float* md = (const float*)(p.ws + OFF_MOD) + (l * 3 + mod_idx(row)) * 6144 + (which == 0 ? 0 : 3072);
    bf16_t* HB = (bf16_t*)(p.ws + OFF_HB);
#pragma unroll
    for (int i = 0; i < 4; ++i) {
      const float4 g = ((const float4*)gp)[lane + i * 64];
      const float4 sh = ((const float4*)md)[lane + i * 64];
      const float4 sc = ((const float4*)(md + 1024))[lane + i * 64];
      const float o0 = v[i].x * rstd * g.x * (1.f + sc.x) + sh.x;
      const float o1 = v[i].y * rstd * g.y * (1.f + sc.y) + sh.y;
      const float o2 = v[i].z * rstd * g.z * (1.f + sc.z) + sh.z;
      const float o3 = v[i].w * rstd * g.w * (1.f + sc.w) + sh.w;
      uint2 pk; pk.x = pack2(o0, o1); pk.y = pack2(o2, o3);
      *(uint2*)(HB + blkA(row, (lane + i * 64) * 4, 32)) = pk;
    }
  }
}

__device__ void phase_norm_conv(const Params& p, int l, char* smem_raw, int which) {
  const int NTR = 4768;
  for (int it = (which == 2 ? NTR : 0) + blockIdx.x; it < (which == 1 ? NTR : NTR + 4096); it += gridDim.x) {
    if (it < NTR) {
      if (it < 2080) {
        const int ktile = it & 15, ntile = it >> 4, n0 = ntile * 64, seg = n0 >> 9;
        int nvalid = 64, src0 = 0;
        if (seg < 16) src0 = seg_start(seg) + (n0 & 511);
        else if (n0 == 8192) { src0 = 3584; nvalid = 16; }
        else nvalid = 0;
        transpose_tile(p.w_in + (size_t)l * 1024 * NPROJ, NPROJ, src0, nvalid, ktile * 64, (bf16_t*)(p.ws + OFF_WT_IN), 1024, n0, smem_raw, true);
      } else if (it < 2464) {
        const int j = it - 2080, br = j >> 7, t = j & 127, ktile = t & 7, ntile = t >> 3;
        const float* src = (br == 0 ? p.w_up_da : br == 1 ? p.w_up_ml : p.w_up_na) + (size_t)l * 512 * 1024;
        transpose_tile(src, 1024, ntile * 64, 64, ktile * 64, (bf16_t*)(p.ws + OFF_WT_UP) + (size_t)br * 1024 * 512, 512, ntile * 64, smem_raw, false);
      } else if (it < 2720) {
        const int t = it - 2464, ktile = t & 15, ntile = t >> 4;
        transpose_tile(p.w_out + (size_t)l * 1024 * 1024, 1024, ntile * 64, 64, ktile * 64, (bf16_t*)(p.ws + OFF_WT_OUT), 1024, ntile * 64, smem_raw, true);
      } else if (it < 3744) {
        const int t = it - 2720, ktile = t & 15, ntile = t >> 4;
        transpose_tile(p.w_ff1 + (size_t)l * 1024 * 4096, 4096, ntile * 64, 64, ktile * 64, (bf16_t*)(p.ws + OFF_WT_FF1), 1024, ntile * 64, smem_raw, true);
      } else {
        const int t = it - 3744, ktile = t & 63, ntile = t >> 6;
        transpose_tile(p.w_ff2 + (size_t)l * 4096 * 1024, 1024, ntile * 64, 64, ktile * 64, (bf16_t*)(p.ws + OFF_WT_FF2), 4096, ntile * 64, smem_raw, true);
      }
    } else {
      norm_row(p, l, (it - NTR) * 4 + (otid() >> 6), 0);
    }
  }
}

__device__ void phase_norm_only(const Params& p, int l, int which) {
  for (int it = blockIdx.x; it < 4096; it += gridDim.x) norm_row(p, l, it * 4 + (otid() >> 6), which);
}

DI void inproj_epilogue(const Params& p, int l, int m0, int n0, int ps, const char* smem_raw) {
  const int tid = otid();
  bf16_t* PROJ = (bf16_t*)(p.ws + OFF_PROJ);
  const float* BINP = (const float*)(p.ws + OFF_BINP) + l * NPAD;
  const float* ROPE = (const float*)(p.ws + OFF_ROPE);
  const float* cst = (const float*)smem_raw;
  const int seg = n0 >> 9;
  const bool lat = m0 >= MCTX;
  const bool do_rope = lat && seg < 2;
  const bool do_sig = (seg == 4) || (seg >= 7 && seg <= 12);
  const float scale = (seg == 0 || seg == 5) ? QSCALE : (seg == 3 ? KSCALE : 1.f);
  bf16_t* trbuf = nullptr;
  if (seg == 3) trbuf = (bf16_t*)(p.ws + OFF_KT_ML);
  else if (seg == 13) trbuf = (bf16_t*)(p.ws + OFF_VT_DA);
  else if (seg == 14) trbuf = (bf16_t*)(p.ws + OFF_VT_ML);
  else if (seg == 15) trbuf = (bf16_t*)(p.ws + OFF_VT_NA);
  float* fout = nullptr;
  if (!lat) {
    if (seg == 1) fout = p.out + OUT_DAK; else if (seg == 6) fout = p.out + OUT_NAK;
    else if (seg == 13) fout = p.out + OUT_DAV; else if (seg == 15) fout = p.out + OUT_NAV;
  }
  {
    const int cr = tid >> 4, c0 = (tid & 15) * 8, ncol0 = n0 + c0;
    float bias[8]; ld8(BINP + ncol0, bias);
    const int dd = ncol0 & 63;
    const int poff = (dd & 16) ? -16 : 16;
    float pbias[8];
    if (do_rope) ld8(BINP + ncol0 + poff, pbias);
#pragma unroll 2
    for (int it = 0; it < 8; ++it) {
      const int rl = it * 16 + cr, row = m0 + rowmap256(rl, ps);
      float v[8]; ld8(cst + rl * CS + c0, v);
#pragma unroll
      for (int e = 0; e < 8; ++e) v[e] += bias[e];
      if (fout) st8(fout + ((size_t)((row >> 8) * 4 + l) * 256 + (row & 255)) * 512 + (ncol0 & 511), v);
      if (do_rope) {
        float pv[8]; ld8(cst + rl * CS + c0 + poff, pv);
        const int pos = (row - MCTX) & 4095;
        const int pp = (dd & 32) ? (pos & 63) : (pos >> 6);
        float cs[8], sn[8];
        ld8(ROPE + pp * 16 + (dd & 8), cs); ld8(ROPE + 1024 + pp * 16 + (dd & 8), sn);
#pragma unroll
        for (int e = 0; e < 8; ++e) {
          const float pe = pv[e] + pbias[e];
          v[e] = (dd & 16) ? (pe * sn[e] + v[e] * cs[e]) : (v[e] * cs[e] - pe * sn[e]);
        }
      }
      if (do_sig) {
#pragma unroll
        for (int e = 0; e < 8; ++e) v[e] = fsigmoid(v[e]);
      } else {
#pragma unroll
        for (int e = 0; e < 8; ++e) v[e] *= scale;
      }
      if (seg <= 12) *(uint4*)(PROJ + (size_t)row * LDP + ncol0) = pack8f(v);
    }
  }
  if (trbuf) {
    const int col = tid & 127, rg = tid >> 7;
    const float bias = BINP[n0 + col];
#pragma unroll 2
    for (int it = 0; it < 8; ++it) {
      const int rb = (it * 2 + rg) * 8;
      float v[8];
#pragma unroll
      for (int e = 0; e < 8; ++e) v[e] = (cst[(rb + e) * CS + col] + bias) * scale;
      *(uint4*)(trbuf + tr_index(m0 + rowmap256(rb, ps), (n0 + col) & 511)) = pack8f(v);
    }
  }
}

__device__ void phase_inproj(const Params& p, int l, char* smem_raw) {
  const bf16_t* HB = (const bf16_t*)(p.ws + OFF_HB);
  const bf16_t* WT = (const bf16_t*)(p.ws + OFF_WT_IN);
  GEMM256_TILE_LOOP(64) {
    const int m0 = mt * 256, n0 = nt * 128;
    f32x16 acc[4][2];
#pragma unroll
    for (int i = 0; i < 4; ++i) { acc[i][0] = zero16(); acc[i][1] = zero16(); }
    gemm_mainloop256(HB, 1024, WT, 1024, 1024, m0, n0, acc, smem_raw);
    stage_acc256<0>(acc, smem_raw);
    inproj_epilogue(p, l, m0, n0, 0, smem_raw);
    stage_acc256<1>(acc, smem_raw);
    inproj_epilogue(p, l, m0, n0, 1, smem_raw);
  }
  {
    const int tid = otid(), lane = tid & 63, wave = tid >> 6, l31 = lane & 31, hh = lane >> 5;
    float* red = (float*)smem_raw;
    float* GATES = (float*)(p.ws + OFF_GATES);
    const float* BINP = (const float*)(p.ws + OFF_BINP) + l * NPAD + 8192;
    for (int it = blockIdx.x; it < 512; it += gridDim.x) {
      const int r0 = it * 32;
      f32x16 acc = zero16();
      const int arow = r0 + l31, brow = 8192 + l31, kbase = wave * 256 + hh * 8;
#pragma unroll 4
      for (int s = 0; s < 16; ++s) {
        bf16x8 a = *(const bf16x8*)(HB + blkA(arow, kbase + s * 16, 32));
        bf16x8 b = *(const bf16x8*)(WT + blkB(brow, kbase + s * 16, 32));
        acc = MFMA32(a, b, acc);
      }
      __syncthreads();
#pragma unroll
      for (int r = 0; r < 16; ++r) red[(wave * 32 + crow(r, hh)) * 33 + l31] = acc[r];
      __syncthreads();
      for (int e = tid; e < 512; e += 256) {
        const int row = e >> 4, c = e & 15;
        GATES[(size_t)(r0 + row) * 16 + c] = red[row * 33 + c] + red[(32 + row) * 33 + c] + red[(64 + row) * 33 + c] + red[(96 + row) * 33 + c] + BINP[c];
      }
    }
  }
}

template <int MODE>
DI void attn_item(const Params& p, int l, int sub, int idx, char* smem_raw) {
  constexpr int DV = MODE == 0 ? 128 : 64;
  constexpr int KW = MODE == 0 ? 128 : 64;
  constexpr int KS = KW + 8, VS = 68;
  constexpr int KBUF = 64 * KS, VBUF = DV * VS;
  constexpr int KCH = KW / 32, VCH = DV / 32, NB = DV / 32;
  bf16_t* sK = (bf16_t*)smem_raw;
  bf16_t* sV = sK + 2 * KBUF;
  float* sRpb = (float*)(sV + 2 * VBUF);
  const int tid = otid(), lane = tid & 63, wave = tid >> 6, l31 = lane & 31, hh = lane >> 5;
  const bf16_t* PROJ = (const bf16_t*)(p.ws + OFF_PROJ);
  bf16_t* OCAT = (bf16_t*)(p.ws + OFF_OCAT);

  int b = 0, head = 0, ntiles = 0, qrow = 0, qcol = 0, coff = 0;
  int start_lo = 0, qr = 0, qc = 0;
  if (MODE == 0) {
    if (sub == 0) { b = idx >> 8; head = (idx >> 6) & 3; qrow = MCTX + b * 4096 + (idx & 63) * 64; ntiles = 72; }
    else { b = idx >> 4; head = (idx >> 2) & 3; qrow = b * 256 + (idx & 3) * 64; ntiles = 4; }
    qrow += (wave & 1) * 32 + l31; coff = (wave >> 1) * 64; qcol = head * 128 + coff;
  } else if (MODE == 1) {
    b = idx >> 4; head = (idx >> 1) & 7; qrow = b * 256 + (idx & 1) * 128 + wave * 32 + l31; ntiles = 4; qcol = 2560 + head * 64;
  } else {
    b = idx >> 8; head = (idx >> 5) & 7;
    const int rp = idx & 31, r0 = rp * 2;
    start_lo = min(max(r0 - 4, 0), 56);
    ntiles = 8 + min(9, 64 - start_lo);
    qr = r0 + (wave >> 1); qc = (wave & 1) * 32 + l31;
    qrow = MCTX + b * 4096 + qr * 64 + qc; qcol = 2560 + head * 64;
  }
  bf16x8 qf[4];
#pragma unroll
  for (int s = 0; s < 4; ++s) qf[s] = *(const bf16x8*)(PROJ + (size_t)qrow * LDP + qcol + s * 16 + hh * 8);

  auto tile_src = [&](int t, const bf16_t*& kp, int& ks, const bf16_t*& vp, int& vs) {
    if (MODE == 0) {
      if (sub == 0) {
        if (t < 64) {
          kp = PROJ + (size_t)(MCTX + b * 4096 + t * 64) * LDP + 512 + head * 128; ks = LDP;
          vp = (const bf16_t*)(p.ws + OFF_VT_DA) + 4194304ull + (size_t)(b * 512 + head * 128) * 4096 + t * 64; vs = 4096;
        } else {
          const int pt = t - 64;
          kp = (const bf16_t*)(p.ws + OFF_KC_DA) + (size_t)((b * 4 + l) * 512 + pt * 64) * 512 + head * 128; ks = 512;
          vp = (const bf16_t*)(p.ws + OFF_VTC_DA) + (size_t)(((b * 4 + l) * 4 + head) * 128) * 512 + pt * 64; vs = 512;
        }
      } else {
        kp = PROJ + (size_t)(b * 256 + t * 64) * LDP + 512 + head * 128; ks = LDP;
        vp = (const bf16_t*)(p.ws + OFF_VT_DA) + (size_t)(b * 512 + head * 128) * 256 + t * 64; vs = 256;
      }
    } else if (MODE == 1) {
      kp = PROJ + (size_t)(b * 256 + t * 64) * LDP + 3072 + head * 64; ks = LDP;
      vp = (const bf16_t*)(p.ws + OFF_VT_NA) + (size_t)(b * 512 + head * 64) * 256 + t * 64; vs = 256;
    } else {
      if (t < 8) {
        kp = (const bf16_t*)(p.ws + OFF_KC_NA) + (size_t)((b * 4 + l) * 512 + t * 64) * 512 + head * 64; ks = 512;
        vp = (const bf16_t*)(p.ws + OFF_VTC_NA) + (size_t)(((b * 4 + l) * 8 + head) * 64) * 512 + t * 64; vs = 512;
      } else {
        const int kr = start_lo + t - 8;
        kp = PROJ + (size_t)(MCTX + b * 4096 + kr * 64) * LDP + 3072 + head * 64; ks = LDP;
        vp = (const bf16_t*)(p.ws + OFF_VT_NA) + 4194304ull + (size_t)(b * 512 + head * 64) * 4096 + kr * 64; vs = 4096;
      }
    }
  };
  uint4 pk0, pk1, pk2, pk3, pv0, pv1, pv2, pv3;
  pk0 = pk1 = pk2 = pk3 = pv0 = pv1 = pv2 = pv3 = make_uint4(0u, 0u, 0u, 0u);
#define KLD_(N_, D_) if (KCH > N_) { const int c_ = tid + N_ * 256, r_ = c_ / (KW / 8), c8_ = c_ % (KW / 8); D_ = *(const uint4*)(kp_ + (size_t)r_ * ks_ + c8_ * 8); }
#define VLD_(N_, D_) if (VCH > N_) { const int c_ = tid + N_ * 256, r_ = c_ >> 3, c8_ = c_ & 7; D_ = *(const uint4*)(vp_ + (size_t)r_ * vs_ + c8_ * 8); }
#define KST_(N_, D_, B_) if (KCH > N_) { const int c_ = tid + N_ * 256, r_ = c_ / (KW / 8), c8_ = c_ % (KW / 8); *(uint4*)(sK + (B_) * KBUF + r_ * KS + c8_ * 8) = D_; }
#define VST_(N_, D_, B_) if (VCH > N_) { const int c_ = tid + N_ * 256, r_ = c_ >> 3, c8_ = c_ & 7; uint2* d_ = (uint2*)(sV + (B_) * VBUF + r_ * VS + c8_ * 8); d_[0] = make_uint2(D_.x, D_.y); d_[1] = make_uint2(D_.z, D_.w); }
#define ATTN_GLOAD(T_) do { \
    const bf16_t* kp_; const bf16_t* vp_; int ks_, vs_; \
    tile_src((T_), kp_, ks_, vp_, vs_); \
    KLD_(0, pk0) KLD_(1, pk1) KLD_(2, pk2) KLD_(3, pk3) VLD_(0, pv0) VLD_(1, pv1) VLD_(2, pv2) VLD_(3, pv3) \
  } while (0)
#define ATTN_SWRITE(B_) do { \
    KST_(0, pk0, B_) KST_(1, pk1, B_) KST_(2, pk2, B_) KST_(3, pk3, B_) VST_(0, pv0, B_) VST_(1, pv1, B_) VST_(2, pv2, B_) VST_(3, pv3, B_) \
  } while (0)

  __syncthreads();
  if (MODE == 2) {
    const float* rp_ = p.na_rpb + (size_t)(l * 8 + head) * 465;
    for (int i = tid; i < 465; i += 256) sRpb[i] = rp_[i] * LOG2E;
  }
  ATTN_GLOAD(0);

  f32x16 O[NB];
#pragma unroll
  for (int i = 0; i < NB; ++i) O[i] = zero16();
  float mrun = 0.f, lrun = 0.f;
  const int cs_ = min(max(qc - 8, 0), 48);
  const int rs_ = min(max(qr - 4, 0), 56);

#pragma unroll 1
  for (int t = 0; t < ntiles; ++t) {
    ATTN_SWRITE(t & 1);
    __syncthreads();
    ATTN_GLOAD(min(t + 1, ntiles - 1));
    __builtin_amdgcn_sched_barrier(0);
    const bf16_t* K = sK + (t & 1) * KBUF;
    const bf16_t* V = sV + (t & 1) * VBUF;
    f32x16 S0, S1;
#pragma unroll
    for (int r = 0; r < 16; ++r) { S0[r] = -mrun; S1[r] = -mrun; }
    {
      bf16x8 ka0[4], ka1[4];
#pragma unroll
      for (int s = 0; s < 4; ++s) {
        ka0[s] = *(const bf16x8*)(K + l31 * KS + coff + s * 16 + hh * 8);
        ka1[s] = *(const bf16x8*)(K + (32 + l31) * KS + coff + s * 16 + hh * 8);
      }
      __builtin_amdgcn_sched_barrier(0);
#pragma unroll
      for (int s = 0; s < 4; ++s) {
        S0 = MFMA32(ka0[s], qf[s], S0);
        S1 = MFMA32(ka1[s], qf[s], S1);
      }
    }
    if (MODE == 2) {
      if (t >= 8) {
        const int kr = start_lo + t - 8;
        const bool rowok = kr >= rs_ && kr < rs_ + 8;
        const int dr = min(max(kr - qr + 7, 0), 14);
#pragma unroll
        for (int r = 0; r < 16; ++r) {
          const int kc0 = crow(r, hh), kc1 = 32 + kc0;
          const bool ok0 = rowok && kc0 >= cs_ && kc0 < cs_ + 16;
          const bool ok1 = rowok && kc1 >= cs_ && kc1 < cs_ + 16;
          const int d0 = min(max(kc0 - qc + 15, 0), 30), d1 = min(max(kc1 - qc + 15, 0), 30);
          S0[r] = ok0 ? S0[r] + sRpb[dr * 31 + d0] : -INFINITY;
          S1[r] = ok1 ? S1[r] + sRpb[dr * 31 + d1] : -INFINITY;
        }
      }
    }
    float mx = S0[0];
#pragma unroll
    for (int r = 1; r < 16; ++r) mx = fmaxf(mx, S0[r]);
#pragma unroll
    for (int r = 0; r < 16; ++r) mx = fmaxf(mx, S1[r]);
    if (__builtin_amdgcn_ballot_w64(mx > 10.f) != 0ull) {
      mx = fmaxf(mx, __shfl_xor(mx, 32));
      const float delta = fmaxf(mx, 0.f);
      const float alpha = fexp2(-delta);
      mrun += delta;
      lrun *= alpha;
#pragma unroll
      for (int r = 0; r < 16; ++r) { S0[r] -= delta; S1[r] -= delta; }
#pragma unroll
      for (int bk = 0; bk < NB; ++bk)
#pragma unroll
        for (int r = 0; r < 16; ++r) O[bk][r] *= alpha;
    }
    float ps = 0.f;
#pragma unroll
    for (int r = 0; r < 16; ++r) { S0[r] = fexp2(S0[r]); ps += S0[r]; }
#pragma unroll
    for (int r = 0; r < 16; ++r) { S1[r] = fexp2(S1[r]); ps += S1[r]; }
    lrun += ps;
#pragma unroll
    for (int kb = 0; kb < 2; ++kb) {
      union { bf16x8 v; uint2 u[2]; } va[2][NB];
#pragma unroll
      for (int s2 = 0; s2 < 2; ++s2)
#pragma unroll
        for (int bk = 0; bk < NB; ++bk) {
          const bf16_t* vr = V + (bk * 32 + l31) * VS + kb * 32 + 16 * s2 + 4 * hh;
          va[s2][bk].u[0] = *(const uint2*)vr;
          va[s2][bk].u[1] = *(const uint2*)(vr + 8);
        }
      const bf16x8 pb0 = (kb == 0) ? pack8(S0, 0) : pack8(S1, 0);
      const bf16x8 pb1 = (kb == 0) ? pack8(S0, 1) : pack8(S1, 1);
      __builtin_amdgcn_sched_barrier(0);
#pragma unroll
      for (int bk = 0; bk < NB; ++bk) O[bk] = MFMA32(va[0][bk].v, pb0, O[bk]);
#pragma unroll
      for (int bk = 0; bk < NB; ++bk) O[bk] = MFMA32(va[1][bk].v, pb1, O[bk]);
      __builtin_amdgcn_sched_barrier(0);
    }
  }
  __syncthreads();
  const float ltot = lrun + __shfl_xor(lrun, 32);
  const float inv = 1.f / ltot;
#pragma unroll
  for (int bk = 0; bk < NB; ++bk)
#pragma unroll
    for (int r = 0; r < 16; ++r) O[bk][r] *= inv;

  if (MODE == 0) {
    float* cmb = (float*)smem_raw;
    if (wave >= 2) {
#pragma unroll
      for (int bk = 0; bk < NB; ++bk)
#pragma unroll
        for (int r = 0; r < 16; ++r) cmb[((bk * 16 + r) * 2 + hh) * 64 + (wave & 1) * 32 + l31] = O[bk][r];
    }
    __syncthreads();
    if (wave < 2) {
      const float lam = ((const float*)(p.ws + OFF_LAM))[l];
      float ss = 0.f;
#pragma unroll
      for (int bk = 0; bk < NB; ++bk)
#pragma unroll
        for (int r = 0; r < 16; ++r) {
          const float d = O[bk][r] - lam * cmb[((bk * 16 + r) * 2 + hh) * 64 + (wave & 1) * 32 + l31];
          O[bk][r] = d; ss += d * d;
        }
      ss += __shfl_xor(ss, 32);
      const float rstd = rsqrtf(ss * (1.f / 128.f) + 1e-6f) * (1.f - lam_init_of(l));
      const float* sub_w = p.da_subln + l * 128;
#pragma unroll
      for (int bk = 0; bk < NB; ++bk)
#pragma unroll
        for (int g = 0; g < 4; ++g) {
          const int dv = bk * 32 + 8 * g + 4 * hh;
          const float4 w4 = *(const float4*)(sub_w + dv);
          uint2 o;
          o.x = pack2(O[bk][4 * g] * rstd * w4.x, O[bk][4 * g + 1] * rstd * w4.y);
          o.y = pack2(O[bk][4 * g + 2] * rstd * w4.z, O[bk][4 * g + 3] * rstd * w4.w);
          *(uint2*)(OCAT + (size_t)qrow * 1536 + head * 128 + dv) = o;
        }
    }
  } else {
#pragma unroll
    for (int bk = 0; bk < NB; ++bk)
#pragma unroll
      for (int g = 0; g < 4; ++g) {
        const int dv = bk * 32 + 8 * g + 4 * hh;
        uint2 o;
        o.x = pack2(O[bk][4 * g], O[bk][4 * g + 1]);
        o.y = pack2(O[bk][4 * g + 2], O[bk][4 * g + 3]);
        *(uint2*)(OCAT + (size_t)qrow * 1536 + 1024 + head * 64 + dv) = o;
      }
  }
}

#define QS_ 136
#define TS_ 72
DI void mlstm_item(const Params& p, int l, int sub, int idx, char* smem_raw) {
  const int tid = otid(), lane = tid & 63, wave = tid >> 6, l31 = lane & 31, hh = lane >> 5;
  bf16_t* Qs = (bf16_t*)smem_raw;
  bf16_t* Ks = Qs + 64 * QS_;
  bf16_t* Kt = Ks + 64 * QS_;
  bf16_t* Vt = Kt + 128 * TS_;
  float* vec = (float*)(Vt + 128 * TS_);
  float* v_gs = vec;
  float* v_bt = vec + 64;
  float* v_inter = vec + 128;
  float* v_emt = vec + 192;
  float* v_w = vec + 256;
  float* v_denp = vec + 320;
  float* v_qn = vec + 448;
  float* v_n = vec + 704;
  float* v_scal = vec + 832;
  bf16_t* sc = Ks;

  const int b = idx >> 3, dir = (idx >> 2) & 1, hd = idx & 3;
  const int T = sub == 0 ? 4096 : 256;
  const int row0 = sub == 0 ? MCTX + b * 4096 : b * 256;
  const int nchunk = T >> 6;
  const size_t trbase = (sub == 0 ? 4194304ull : 0ull) + (size_t)(b * 512 + hd * 128) * T;
  const bf16_t* PROJ = (const bf16_t*)(p.ws + OFF_PROJ);
  const bf16_t* KTG = (const bf16_t*)(p.ws + OFF_KT_ML) + trbase;
  const bf16_t* VTG = (const bf16_t*)(p.ws + OFF_VT_ML) + trbase;
  const float* GATES = (const float*)(p.ws + OFF_GATES);
  bf16_t* HML = (bf16_t*)(p.ws + OFF_HB) + (size_t)dir * MTOT * 512;

  f32x16 Cacc[4];
  float nreg = 0.f, mm = 0.f;
  __syncthreads();
  if (sub == 0) {
    const size_t sidx = (size_t)(((b * 4 + l) * 2 + dir) * 4 + hd);
    const float* C0 = p.state_C + sidx * 16384;
#pragma unroll
    for (int db = 0; db < 4; ++db)
#pragma unroll
      for (int r = 0; r < 16; ++r) Cacc[db][r] = C0[(size_t)(db * 32 + crow(r, hh)) * 128 + wave * 32 + l31];
    if (tid < 128) nreg = p.state_n[sidx * 128 + tid];
    mm = p.state_m[sidx];
  } else {
#pragma unroll
    for (int db = 0; db < 4; ++db) Cacc[db] = zero16();
  }
  if (tid < 128) v_n[tid] = nreg;

#pragma unroll 1
  for (int jc = 0; jc < nchunk; ++jc) {
    const int ch = dir ? nchunk - 1 - jc : jc;
    const int tok0 = ch * 64;
    const int tid = otid(), lane = tid & 63, wave = tid >> 6, l31 = lane & 31, hh = lane >> 5;
    __syncthreads();
#pragma unroll
    for (int i = 0; i < 4; ++i) {
      const int c = tid + i * 256, r = c >> 4, c8 = c & 15;
      const bf16_t* src = PROJ + (size_t)(row0 + tok0 + r) * LDP + hd * 128 + c8 * 8;
      *(uint4*)(Qs + r * QS_ + c8 * 8) = *(const uint4*)(src + 1024);
      *(uint4*)(Ks + r * QS_ + c8 * 8) = *(const uint4*)(src + 1536);
    }
    __builtin_amdgcn_sched_barrier(0);
#pragma unroll
    for (int i = 0; i < 4; ++i) {
      const int c = tid + i * 256, d = c >> 3, c8 = c & 7;
      *(uint4*)(Kt + d * TS_ + c8 * 8) = *(const uint4*)(KTG + (size_t)d * T + tok0 + c8 * 8);
      *(uint4*)(Vt + d * TS_ + c8 * 8) = *(const uint4*)(VTG + (size_t)d * T + tok0 + c8 * 8);
    }
    if (wave == 0) {
      const int t = dir ? 63 - lane : lane;
      const float* gp = GATES + (size_t)(row0 + tok0 + t) * 16 + dir * 8 + hd;
      const float ig = gp[0], fg = gp[4];
      const float lf = fminf(fg, 0.f) - flog1pexp(fabsf(fg));
      float bc = lf;
#pragma unroll
      for (int off = 1; off < 64; off <<= 1) { const float o = __shfl_up(bc, off); if (lane >= off) bc += o; }
      const float gs = ig - bc;
      float pm = gs;
#pragma unroll
      for (int off = 1; off < 64; off <<= 1) { const float o = __shfl_up(pm, off); if (lane >= off) pm = fmaxf(pm, o); }
      const float mt_ = bc + fmaxf(mm, pm);
      const float bc_last = __shfl(bc, 63), m_new = __shfl(mt_, 63);
      v_gs[t] = gs; v_bt[t] = bc - mt_; v_inter[t] = fexp(bc + mm - mt_); v_emt[t] = fexp(-mt_);
      v_w[t] = fexp(bc_last + gs - m_new);
      if (lane == 0) { v_scal[0] = fexp(bc_last + mm - m_new); v_scal[1] = m_new; }
    }
    __syncthreads();
    const float decay = v_scal[0];
    mm = v_scal[1];
    const int sb = wave >> 1, tb = wave & 1;
    {
      f32x16 S = zero16();
#pragma unroll
      for (int kk = 0; kk < 8; ++kk) {
        bf16x8 a = *(const bf16x8*)(Ks + (sb * 32 + l31) * QS_ + kk * 16 + hh * 8);
        bf16x8 bq = *(const bf16x8*)(Qs + (tb * 32 + l31) * QS_ + kk * 16 + hh * 8);
        S = MFMA32(a, bq, S);
      }
      const int t = tb * 32 + l31;
      const float btv = v_bt[t];
      float dsum = 0.f;
#pragma unroll
      for (int r = 0; r < 16; ++r) {
        const int s = sb * 32 + crow(r, hh);
        const bool ok = dir ? (s >= t) : (s <= t);
        const float val = ok ? S[r] * fexp(btv + v_gs[s]) : 0.f;
        S[r] = val; dsum += val;
      }
      dsum += __shfl_xor(dsum, 32);
      if (hh == 0) v_denp[sb * 64 + t] = dsum;
      {
        const int tq = tid & 63, part = tid >> 6;
        float a = 0.f;
#pragma unroll
        for (int c8 = 0; c8 < 4; ++c8) {
          const uint4 qv = *(const uint4*)(Qs + tq * QS_ + part * 32 + c8 * 8);
          const float* nn = v_n + part * 32 + c8 * 8;
          a += bflo(qv.x) * nn[0] + bfhi(qv.x) * nn[1] + bflo(qv.y) * nn[2] + bfhi(qv.y) * nn[3]
             + bflo(qv.z) * nn[4] + bfhi(qv.z) * nn[5] + bflo(qv.w) * nn[6] + bfhi(qv.w) * nn[7];
        }
        v_qn[part * 64 + tq] = a;
      }
      __syncthreads();
#pragma unroll
      for (int g = 0; g < 4; ++g) {
        uint2 o; o.x = pack2(S[4 * g], S[4 * g + 1]); o.y = pack2(S[4 * g + 2], S[4 * g + 3]);
        *(uint2*)(sc + t * TS_ + sb * 32 + 8 * g + 4 * hh) = o;
      }
    }
    __syncthreads();
    bf16x8 Cbf[4][2];
#pragma unroll
    for (int db = 0; db < 4; ++db) { Cbf[db][0] = pack8(Cacc[db], 0); Cbf[db][1] = pack8(Cacc[db], 1); }
#pragma unroll
    for (int tb2 = 0; tb2 < 2; ++tb2) {
      const int t = tb2 * 32 + l31;
      f32x16 acc = zero16();
#pragma unroll
      for (int db = 0; db < 4; ++db)
#pragma unroll
        for (int s2 = 0; s2 < 2; ++s2) {
          const bf16_t* qp = Qs + t * QS_ + db * 32 + 16 * s2 + 4 * hh;
          union { bf16x8 v; uint2 u[2]; } bq;
          bq.u[0] = *(const uint2*)qp; bq.u[1] = *(const uint2*)(qp + 8);
          acc = MFMA32(Cbf[db][s2], bq.v, acc);
        }
      const float it_ = v_inter[t];
#pragma unroll
      for (int r = 0; r < 16; ++r) acc[r] *= it_;
#pragma unroll
      for (int kk = 0; kk < 4; ++kk) {
        bf16x8 a = *(const bf16x8*)(Vt + (wave * 32 + l31) * TS_ + kk * 16 + hh * 8);
        bf16x8 bs = *(const bf16x8*)(sc + t * TS_ + kk * 16 + hh * 8);
        acc = MFMA32(a, bs, acc);
      }
      const float den = it_ * (v_qn[t] + v_qn[64 + t] + v_qn[128 + t] + v_qn[192 + t]) + v_denp[t] + v_denp[64 + t];
      const float rdn = 1.f / fmaxf(fabsf(den), v_emt[t]);
      bf16_t* hp = HML + (size_t)(row0 + tok0 + t) * 512 + hd * 128 + wave * 32 + 4 * hh;
#pragma unroll
      for (int g = 0; g < 4; ++g) {
        uint2 o; o.x = pack2(acc[4 * g] * rdn, acc[4 * g + 1] * rdn); o.y = pack2(acc[4 * g + 2] * rdn, acc[4 * g + 3] * rdn);
        *(uint2*)(hp + 8 * g) = o;
      }
    }
    {
      bf16x8 bw[4];
#pragma unroll
      for (int kk = 0; kk < 4; ++kk) {
        const uint4 vv = *(const uint4*)(Vt + (wave * 32 + l31) * TS_ + kk * 16 + hh * 8);
        const float* ww = v_w + kk * 16 + hh * 8;
        union { bf16x8 v; unsigned u[4]; } o;
        o.u[0] = pack2(bflo(vv.x) * ww[0], bfhi(vv.x) * ww[1]);
        o.u[1] = pack2(bflo(vv.y) * ww[2], bfhi(vv.y) * ww[3]);
        o.u[2] = pack2(bflo(vv.z) * ww[4], bfhi(vv.z) * ww[5]);
        o.u[3] = pack2(bflo(vv.w) * ww[6], bfhi(vv.w) * ww[7]);
        bw[kk] = o.v;
      }
#pragma unroll
      for (int db = 0; db < 4; ++db) {
#pragma unroll
        for (int r = 0; r < 16; ++r) Cacc[db][r] *= decay;
#pragma unroll
        for (int kk = 0; kk < 4; ++kk) {
          bf16x8 a = *(const bf16x8*)(Kt + (db * 32 + l31) * TS_ + kk * 16 + hh * 8);
          Cacc[db] = MFMA32(a, bw[kk], Cacc[db]);
        }
      }
      if (tid < 128) {
        float a = 0.f;
#pragma unroll
        for (int c8 = 0; c8 < 8; ++c8) {
          const uint4 kv = *(const uint4*)(Kt + tid * TS_ + c8 * 8);
          const float* ww = v_w + c8 * 8;
          a += bflo(kv.x) * ww[0] + bfhi(kv.x) * ww[1] + bflo(kv.y) * ww[2] + bfhi(kv.y) * ww[3]
             + bflo(kv.z) * ww[4] + bfhi(kv.z) * ww[5] + bflo(kv.w) * ww[6] + bfhi(kv.w) * ww[7];
        }
        nreg = decay * nreg + a;
        v_n[tid] = nreg;
      }
    }
  }
  if (sub == 1) {
    const size_t sidx = (size_t)(((b * 4 + l) * 2 + dir) * 4 + hd);
    float* Co = p.out + OUT_MLC + sidx * 16384;
#pragma unroll
    for (int db = 0; db < 4; ++db)
#pragma unroll
      for (int r = 0; r < 16; ++r) Co[(size_t)(db * 32 + crow(r, hh)) * 128 + wave * 32 + l31] = Cacc[db][r];
    if (tid < 128) p.out[OUT_MLN + sidx * 128 + tid] = nreg;
    if (tid == 0) p.out[OUT_MLM + sidx] = mm;
  }
}

DI void ml_gate_scan(const float* GATES, int rowtok0, int dir, int hd, float mm, int lane,
                     float* v_gs, float* v_bt, float* v_inter, float* v_emt, float* v_w, float* v_scal, bool full) {
  const int t = dir ? 63 - lane : lane;
  const float* gp = GATES + (size_t)(rowtok0 + t) * 16 + dir * 8 + hd;
  const float ig = gp[0], fg = gp[4];
  const float lf = fminf(fg, 0.f) - flog1pexp(fabsf(fg));
  float bc = lf;
#pragma unroll
  for (int off = 1; off < 64; off <<= 1) { const float o = __shfl_up(bc, off); if (lane >= off) bc += o; }
  const float gs = ig - bc;
  float pm = gs;
#pragma unroll
  for (int off = 1; off < 64; off <<= 1) { const float o = __shfl_up(pm, off); if (lane >= off) pm = fmaxf(pm, o); }
  const float mt_ = bc + fmaxf(mm, pm);
  const float bc_last = __shfl(bc, 63), m_new = __shfl(mt_, 63);
  if (full) { v_gs[t] = gs; v_bt[t] = bc - mt_; v_inter[t] = fexp(bc + mm - mt_); v_emt[t] = fexp(-mt_); }
  v_w[t] = fexp(bc_last + gs - m_new);
  if (lane == 0) { v_scal[0] = fexp(bc_last + mm - m_new); v_scal[1] = m_new; }
}

DI void lat_a_item(const Params& p, int l, int idx, char* smem_raw) {
  const int c = idx >> 3, g = idx & 7;
  const int b = c >> 3, dir = (c >> 2) & 1, hd = c & 3;
  bf16_t* Kt = (bf16_t*)smem_raw;
  bf16_t* Vt = Kt + 128 * TS_;
  float* vec = (float*)(Vt + 128 * TS_);
  float* v_w = vec; float* v_mm = vec + 64; float* v_scal = vec + 128;
  const int row0 = MCTX + b * 4096;
  const size_t trbase = 4194304ull + (size_t)(b * 512 + hd * 128) * 4096;
  const bf16_t* KTG = (const bf16_t*)(p.ws + OFF_KT_ML) + trbase;
  const bf16_t* VTG = (const bf16_t*)(p.ws + OFF_VT_ML) + trbase;
  const float* GATES = (const float*)(p.ws + OFF_GATES);
  float* SC = (float*)(p.ws + OFF_SC);
  float* DN = (float*)(p.ws + OFF_DN);
  bf16_t* DC = (bf16_t*)(p.ws + OFF_DC);
  const size_t sidx = (size_t)(((b * 4 + l) * 2 + dir) * 4 + hd);
  {
    const int tid = otid(), lane = tid & 63, wave = tid >> 6;
    __syncthreads();
    if (wave == 0) {
      const int chL = dir ? 63 - lane : lane;
      const float* gp = GATES + (size_t)(row0 + chL * 64) * 16 + dir * 8 + hd;
      float bc = 0.f, A = -INFINITY;
#pragma unroll 8
      for (int i = 0; i < 64; ++i) {
        const int t = dir ? 63 - i : i;
        const float ig = gp[t * 16], fg = gp[t * 16 + 4];
        bc += fminf(fg, 0.f) - flog1pexp(fabsf(fg));
        A = fmaxf(A, ig - bc);
      }
      float mm = p.state_m[sidx], mine = 0.f;
      for (int jj = 0; jj < 64; ++jj) {
        const float bb = __shfl(bc, jj), aa = __shfl(A, jj);
        if (lane == jj) mine = mm;
        mm = bb + fmaxf(mm, aa);
      }
      v_mm[lane] = mine;
      if (g == 0) SC[(c * 64 + lane) * 2 + 1] = mine;
    }
  }
#pragma unroll 1
  for (int q = 0; q < 8; ++q) {
    const int j = g * 8 + q, ch = dir ? 63 - j : j, tok0 = ch * 64;
    const int tid = otid(), lane = tid & 63, wave = tid >> 6, l31 = lane & 31, hh = lane >> 5;
    __syncthreads();
#pragma unroll
    for (int i = 0; i < 4; ++i) {
      const int cc = tid + i * 256, d = cc >> 3, c8 = cc & 7;
      *(uint4*)(Kt + d * TS_ + c8 * 8) = *(const uint4*)(KTG + (size_t)d * 4096 + tok0 + c8 * 8);
      *(uint4*)(Vt + d * TS_ + c8 * 8) = *(const uint4*)(VTG + (size_t)d * 4096 + tok0 + c8 * 8);
    }
    if (wave == 0) ml_gate_scan(GATES, row0 + tok0, dir, hd, v_mm[j], lane, nullptr, nullptr, nullptr, nullptr, v_w, v_scal, false);
    __syncthreads();
    bf16x8 bw[4];
#pragma unroll
    for (int kk = 0; kk < 4; ++kk) {
      const uint4 vv = *(const uint4*)(Vt + (wave * 32 + l31) * TS_ + kk * 16 + hh * 8);
      const float* ww = v_w + kk * 16 + hh * 8;
      union { bf16x8 v; unsigned u[4]; } o;
      o.u[0] = pack2(bflo(vv.x) * ww[0], bfhi(vv.x) * ww[1]);
      o.u[1] = pack2(bflo(vv.y) * ww[2], bfhi(vv.y) * ww[3]);
      o.u[2] = pack2(bflo(vv.z) * ww[4], bfhi(vv.z) * ww[5]);
      o.u[3] = pack2(bflo(vv.w) * ww[6], bfhi(vv.w) * ww[7]);
      bw[kk] = o.v;
    }
    bf16_t* dcp = DC + (size_t)(c * 64 + j) * 16384;
#pragma unroll
    for (int db = 0; db < 4; ++db) {
      f32x16 acc = zero16();
#pragma unroll
      for (int kk = 0; kk < 4; ++kk) {
        bf16x8 a = *(const bf16x8*)(Kt + (db * 32 + l31) * TS_ + kk * 16 + hh * 8);
        acc = MFMA32(a, bw[kk], acc);
      }
      *(bf16x8*)(dcp + (size_t)(((wave * 4 + db) * 2 + 0) * 64 + lane) * 8) = pack8(acc, 0);
      *(bf16x8*)(dcp + (size_t)(((wave * 4 + db) * 2 + 1) * 64 + lane) * 8) = pack8(acc, 1);
    }
    if (tid < 128) {
      float a = 0.f;
#pragma unroll
      for (int c8 = 0; c8 < 8; ++c8) {
        const uint4 kv = *(const uint4*)(Kt + tid * TS_ + c8 * 8);
        const float* ww = v_w + c8 * 8;
        a += bflo(kv.x) * ww[0] + bfhi(kv.x) * ww[1] + bflo(kv.y) * ww[2] + bfhi(kv.y) * ww[3]
           + bflo(kv.z) * ww[4] + bfhi(kv.z) * ww[5] + bflo(kv.w) * ww[6] + bfhi(kv.w) * ww[7];
      }
      DN[(size_t)(c * 64 + j) * 128 + tid] = a;
    }
    if (tid == 0) SC[(c * 64 + j) * 2] = v_scal[0];
  }
}

DI void lat_scan_item(const Params& p, int l, int idx) {
  const int c = idx >> 3, part = idx & 7;
  const int b = c >> 3, dir = (c >> 2) & 1, hd = c & 3;
  const int tid = otid();
  const float* SC = (const float*)(p.ws + OFF_SC) + c * 128;
  const size_t sidx = (size_t)(((b * 4 + l) * 2 + dir) * 4 + hd);
  const int idx8 = part * 256 + tid;
  const int ln = idx8 & 63, s2 = (idx8 >> 6) & 1, db = (idx8 >> 7) & 3, wv = (idx8 >> 9) & 3;
  const int e = wv * 32 + (ln & 31), hh = ln >> 5;
  float cr[8];
#pragma unroll
  for (int jj = 0; jj < 8; ++jj) {
    const int d = db * 32 + 16 * s2 + 8 * (jj >> 2) + 4 * hh + (jj & 3);
    cr[jj] = p.state_C[sidx * 16384 + (size_t)d * 128 + e];
  }
  uint4* Dp = (uint4*)(p.ws + OFF_DC) + (size_t)c * 64 * 2048 + idx8;
#pragma unroll 4
  for (int j = 0; j < 64; ++j) {
    const float decay = SC[j * 2];
    const uint4 t = Dp[(size_t)j * 2048];
    Dp[(size_t)j * 2048] = pack8f(cr);
    cr[0] = decay * cr[0] + bflo(t.x); cr[1] = decay * cr[1] + bfhi(t.x);
    cr[2] = decay * cr[2] + bflo(t.y); cr[3] = decay * cr[3] + bfhi(t.y);
    cr[4] = decay * cr[4] + bflo(t.z); cr[5] = decay * cr[5] + bfhi(t.z);
    cr[6] = decay * cr[6] + bflo(t.w); cr[7] = decay * cr[7] + bfhi(t.w);
  }
  if (part == 0 && tid < 128) {
    float* DN = (float*)(p.ws + OFF_DN) + (size_t)c * 64 * 128 + tid;
    float nr = p.state_n[sidx * 128 + tid];
#pragma unroll 4
    for (int j = 0; j < 64; ++j) {
      const float decay = SC[j * 2];
      const float t = DN[j * 128];
      DN[j * 128] = nr;
      nr = decay * nr + t;
    }
  }
}

DI void lat_c_item(const Params& p, int l, int idx, char* smem_raw) {
  const int c = idx >> 6, j = idx & 63;
  const int b = c >> 3, dir = (c >> 2) & 1, hd = c & 3;
  const int tid = otid(), lane = tid & 63, wave = tid >> 6, l31 = lane & 31, hh = lane >> 5;
  bf16_t* Qs = (bf16_t*)smem_raw;
  bf16_t* Ks = Qs + 64 * QS_;
  bf16_t* Vt = Ks + 64 * QS_;
  float* vec = (float*)(Vt + 128 * TS_);
  float* v_gs = vec; float* v_bt = vec + 64; float* v_inter = vec + 128; float* v_emt = vec + 192; float* v_w = vec + 256;
  float* v_denp = vec + 320; float* v_qn = vec + 448; float* v_n = vec + 704; float* v_scal = vec + 832;
  bf16_t* sc = Ks;
  const int row0 = MCTX + b * 4096;
  const int ch = dir ? 63 - j : j, tok0 = ch * 64;
  const size_t trbase = 4194304ull + (size_t)(b * 512 + hd * 128) * 4096;
  const bf16_t* PROJ = (const bf16_t*)(p.ws + OFF_PROJ);
  const bf16_t* VTG = (const bf16_t*)(p.ws + OFF_VT_ML) + trbase;
  const float* GATES = (const float*)(p.ws + OFF_GATES);
  const float* SC = (const float*)(p.ws + OFF_SC);
  const float* DN = (const float*)(p.ws + OFF_DN);
  const bf16_t* DC = (const bf16_t*)(p.ws + OFF_DC) + (size_t)(c * 64 + j) * 16384;
  bf16_t* HML = (bf16_t*)(p.ws + OFF_HB) + (size_t)dir * MTOT * 512;
  __syncthreads();
#pragma unroll
  for (int i = 0; i < 4; ++i) {
    const int cc = tid + i * 256, r = cc >> 4, c8 = cc & 15;
    const bf16_t* src = PROJ + (size_t)(row0 + tok0 + r) * LDP + hd * 128 + c8 * 8;
    *(uint4*)(Qs + r * QS_ + c8 * 8) = *(const uint4*)(src + 1024);
    *(uint4*)(Ks + r * QS_ + c8 * 8) = *(const uint4*)(src + 1536);
  }
#pragma unroll
  for (int i = 0; i < 4; ++i) {
    const int cc = tid + i * 256, d = cc >> 3, c8 = cc & 7;
    *(uint4*)(Vt + d * TS_ + c8 * 8) = *(const uint4*)(VTG + (size_t)d * 4096 + tok0 + c8 * 8);
  }
  if (wave == 0) ml_gate_scan(GATES, row0 + tok0, dir, hd, SC[(c * 64 + j) * 2 + 1], lane, v_gs, v_bt, v_inter, v_emt, v_w, v_scal, true);
  if (tid >= 128) v_n[tid - 128] = DN[(size_t)(c * 64 + j) * 128 + tid - 128];
  __syncthreads();
  const int sb = wave >> 1, tb = wave & 1;
  {
    f32x16 S = zero16();
#pragma unroll
    for (int kk = 0; kk < 8; ++kk) {
      bf16x8 a = *(const bf16x8*)(Ks + (sb * 32 + l31) * QS_ + kk * 16 + hh * 8);
      bf16x8 bq = *(const bf16x8*)(Qs + (tb * 32 + l31) * QS_ + kk * 16 + hh * 8);
      S = MFMA32(a, bq, S);
    }
    const int t = tb * 32 + l31;
    const float btv = v_bt[t];
    float dsum = 0.f;
#pragma unroll
    for (int r = 0; r < 16; ++r) {
      const int s = sb * 32 + crow(r, hh);
      const bool ok = dir ? (s >= t) : (s <= t);
      const float val = ok ? S[r] * fexp(btv + v_gs[s]) : 0.f;
      S[r] = val; dsum += val;
    }
    dsum += __shfl_xor(dsum, 32);
    if (hh == 0) v_denp[sb * 64 + t] = dsum;
    {
      const int tq = tid & 63, part = tid >> 6;
      float a = 0.f;
#pragma unroll
      for (int c8 = 0; c8 < 4; ++c8) {
        const uint4 qv = *(const uint4*)(Qs + tq * QS_ + part * 32 + c8 * 8);
        const float* nn = v_n + part * 32 + c8 * 8;
        a += bflo(qv.x) * nn[0] + bfhi(qv.x) * nn[1] + bflo(qv.y) * nn[2] + bfhi(qv.y) * nn[3]
           + bflo(qv.z) * nn[4] + bfhi(qv.z) * nn[5] + bflo(qv.w) * nn[6] + bfhi(qv.w) * nn[7];
      }
      v_qn[part * 64 + tq] = a;
    }
    __syncthreads();
#pragma unroll
    for (int g = 0; g < 4; ++g) {
      uint2 o; o.x = pack2(S[4 * g], S[4 * g + 1]); o.y = pack2(S[4 * g + 2], S[4 * g + 3]);
      *(uint2*)(sc + t * TS_ + sb * 32 + 8 * g + 4 * hh) = o;
    }
  }
  bf16x8 Cbf[4][2];
#pragma unroll
  for (int db = 0; db < 4; ++db) {
    Cbf[db][0] = *(const bf16x8*)(DC + (size_t)(((wave * 4 + db) * 2 + 0) * 64 + lane) * 8);
    Cbf[db][1] = *(const bf16x8*)(DC + (size_t)(((wave * 4 + db) * 2 + 1) * 64 + lane) * 8);
  }
  __syncthreads();
#pragma unroll
  for (int tb2 = 0; tb2 < 2; ++tb2) {
    const int t = tb2 * 32 + l31;
    f32x16 acc = zero16();
#pragma unroll
    for (int db = 0; db < 4; ++db)
#pragma unroll
      for (int s2 = 0; s2 < 2; ++s2) {
        const bf16_t* qp = Qs + t * QS_ + db * 32 + 16 * s2 + 4 * hh;
        union { bf16x8 v; uint2 u[2]; } bq;
        bq.u[0] = *(const uint2*)qp; bq.u[1] = *(const uint2*)(qp + 8);
        acc = MFMA32(Cbf[db][s2], bq.v, acc);
      }
    const float it_ = v_inter[t];
#pragma unroll
    for (int r = 0; r < 16; ++r) acc[r] *= it_;
#pragma unroll
    for (int kk = 0; kk < 4; ++kk) {
      bf16x8 a = *(const bf16x8*)(Vt + (wave * 32 + l31) * TS_ + kk * 16 + hh * 8);
      bf16x8 bs = *(const bf16x8*)(sc + t * TS_ + kk * 16 + hh * 8);
      acc = MFMA32(a, bs, acc);
    }
    const float den = it_ * (v_qn[t] + v_qn[64 + t] + v_qn[128 + t] + v_qn[192 + t]) + v_denp[t] + v_denp[64 + t];
    const float rdn = 1.f / fmaxf(fabsf(den), v_emt[t]);
    bf16_t* hp = HML + (size_t)(row0 + tok0 + t) * 512 + hd * 128 + wave * 32 + 4 * hh;
#pragma unroll
    for (int g = 0; g < 4; ++g) {
      uint2 o; o.x = pack2(acc[4 * g] * rdn, acc[4 * g + 1] * rdn); o.y = pack2(acc[4 * g + 2] * rdn, acc[4 * g + 3] * rdn);
      *(uint2*)(hp + 8 * g) = o;
    }
  }
}

__device__ void phase_lat_scan(const Params& p, int l) {
  for (int it = blockIdx.x; it < 128; it += gridDim.x) if (LATMASK & 2) lat_scan_item(p, l, it);
}
__device__ void phase_lat_c(const Params& p, int l, char* smem_raw) {
  for (int it = blockIdx.x; it < 1024; it += gridDim.x) if (LATMASK & 4) lat_c_item(p, l, it, smem_raw);
}

__device__ void phase_mixers(const Params& p, int lc, char* smem_raw, int* s_item) {
  int* ctr = (int*)(p.ws + OFF_CTR) + lc;
  const int l = lc & 3;
  int* ctrDA = (int*)(p.ws + OFF_CTR) + 16 + l * 8;
  int q = (int)(xb_xcc_id() & 7u), tries = 0;
  bool da_done = false;
  while (true) {
    __syncthreads();
    if (threadIdx.x == 0) {
      int code = -1;
      while (!da_done) {
        const int i = atomicAdd(&ctrDA[q], 1);
        if (i < 64) { code = (1 << 20) | (q * 64 + i); break; }
        q = (q + 1) & 7;
        if (++tries == 8) da_done = true;
      }
      if (code < 0) {
        const int it = atomicAdd(ctr, 1);
        code = it < 1920 ? it : -1;
      }
      *s_item = code;
    }
    __syncthreads();
    const int code = *s_item;
    if (code < 0) break;
    int kind, sub = 0, idx;
    if (code & (1 << 20)) { kind = 1; sub = 0; idx = code & 0xfffff; }
    else if (code < 256) { kind = 0; idx = code; }
    else if (code < 384) { kind = 4; idx = code - 256; }
    else if (code < 896) { kind = 2; idx = code - 384; }
    else if (code < 1408) { kind = 1; sub = 1; idx = code - 896; }
    else { kind = 3; idx = code - 1408; }
#ifndef MXMASK
#define MXMASK 15
#endif
#ifndef PROBE_KIND
#define PROBE_KIND -1
#endif
    for (int r2 = 0; r2 < ((kind * 2 + sub == PROBE_KIND) ? 2 : 1); ++r2) {
    if (kind == 4) { if (LATMASK & 1) lat_a_item(p, l, idx, smem_raw); }
    else if (kind == 0) { if (MXMASK & 1) mlstm_item(p, l, 1, idx, smem_raw); }
    else if (kind == 1) { if (MXMASK & 2) attn_item<0>(p, l, sub, idx, smem_raw); }
    else if (kind == 2) { if (MXMASK & 4) attn_item<2>(p, l, 0, idx, smem_raw); }
    else { if (MXMASK & 8) attn_item<1>(p, l, 0, idx, smem_raw); }
    }
  }
}

__device__ void phase_mlpost(const Params& p, int l) {
  const int lane = otid() & 63, wave = otid() >> 6;
  const bf16_t* HF = (const bf16_t*)(p.ws + OFF_HB);
  const bf16_t* HBW = HF + (size_t)MTOT * 512;
  const bf16_t* PROJ = (const bf16_t*)(p.ws + OFF_PROJ);
  bf16_t* OCAT = (bf16_t*)(p.ws + OFF_OCAT);
  const float* gw = p.ml_norm + l * 512 + lane * 8;
  for (int it = blockIdx.x; it < 4096; it += gridDim.x) {
    const int row = it * 4 + wave;
    const uint4 a = *(const uint4*)(HF + (size_t)row * 512 + lane * 8);
    const uint4 c = *(const uint4*)(HBW + (size_t)row * 512 + lane * 8);
    const uint4 g = *(const uint4*)(PROJ + (size_t)row * LDP + 2048 + lane * 8);
    float v[8];
    v[0] = bflo(a.x) + bflo(c.x); v[1] = bfhi(a.x) + bfhi(c.x); v[2] = bflo(a.y) + bflo(c.y); v[3] = bfhi(a.y) + bfhi(c.y);
    v[4] = bflo(a.z) + bflo(c.z); v[5] = bfhi(a.z) + bfhi(c.z); v[6] = bflo(a.w) + bflo(c.w); v[7] = bfhi(a.w) + bfhi(c.w);
    float ss = 0.f;
#pragma unroll
    for (int i = 0; i < 8; ++i) ss += v[i] * v[i];
#pragma unroll
    for (int off = 8; off >= 1; off >>= 1) ss += __shfl_xor(ss, off);
    const float rstd = rsqrtf(ss * (1.f / 128.f) + 1e-6f);
    const float4 w0 = *(const float4*)gw, w1 = *(const float4*)(gw + 4);
    uint4 o;
    o.x = pack2(v[0] * rstd * w0.x * bflo(g.x), v[1] * rstd * w0.y * bfhi(g.x));
    o.y = pack2(v[2] * rstd * w0.z * bflo(g.y), v[3] * rstd * w0.w * bfhi(g.y));
    o.z = pack2(v[4] * rstd * w1.x * bflo(g.z), v[5] * rstd * w1.y * bfhi(g.z));
    o.w = pack2(v[6] * rstd * w1.z * bflo(g.w), v[7] * rstd * w1.w * bfhi(g.w));
    *(uint4*)(OCAT + (size_t)row * 1536 + 512 + lane * 8) = o;
  }
}

__device__ void phase_upproj(const Params& p, int l, char* smem_raw) {
  const int tid = otid();
  const bf16_t* OCAT = (const bf16_t*)(p.ws + OFF_OCAT);
  const bf16_t* WT = (const bf16_t*)(p.ws + OFF_WT_UP);
  const bf16_t* PROJ = (const bf16_t*)(p.ws + OFF_PROJ);
  bf16_t* HB = (bf16_t*)(p.ws + OFF_HB);
  const float* cst = (const float*)smem_raw;
  const int cr = tid >> 4, c0 = (tid & 15) * 8;
  GEMM_TILE_LOOP(8) {
    const int m0 = mt * 128, n0 = nt * 128;
    uint4 tot[8];
#pragma unroll
    for (int it = 0; it < 8; ++it) tot[it] = make_uint4(0u, 0u, 0u, 0u);
    for (int br = 0; br < 3; ++br) {
      f32x16 acc[2][2];
      acc[0][0] = zero16(); acc[0][1] = zero16(); acc[1][0] = zero16(); acc[1][1] = zero16();
      gemm_mainloop(OCAT + br * 512, 1536, WT + (size_t)br * 1024 * 512, 512, 512, m0, n0, acc, smem_raw);
      stage_acc(acc, smem_raw);
#pragma unroll
      for (int it = 0; it < 8; ++it) {
        const int rl = it * 16 + cr, row = m0 + rl;
        float v[8]; ld8(cst + rl * CS + c0, v);
        const uint4 g = *(const uint4*)(PROJ + (size_t)row * LDP + 3584 + br * 1024 + n0 + c0);
        tot[it].x = pack2(bflo(tot[it].x) + bflo(g.x) * v[0], bfhi(tot[it].x) + bfhi(g.x) * v[1]);
        tot[it].y = pack2(bflo(tot[it].y) + bflo(g.y) * v[2], bfhi(tot[it].y) + bfhi(g.y) * v[3]);
        tot[it].z = pack2(bflo(tot[it].z) + bflo(g.z) * v[4], bfhi(tot[it].z) + bfhi(g.z) * v[5]);
        tot[it].w = pack2(bflo(tot[it].w) + bflo(g.w) * v[6], bfhi(tot[it].w) + bfhi(g.w) * v[7]);
      }
    }
#pragma unroll
    for (int it = 0; it < 8; ++it) {
      const int row = m0 + it * 16 + cr;
      *(uint4*)(HB + blkA(row, n0 + c0, 32)) = tot[it];
    }
  }
}

DI void res_epilogue(const Params& p, int l, int kind, int m0, int n0, int ps, const char* smem_raw) {
  const int tid = otid();
  bf16_t* U = (bf16_t*)(p.ws + OFF_PROJ);
  float* X = (float*)(p.ws + OFF_X);
  const float* MOD = (const float*)(p.ws + OFF_MOD) + l * 3 * 6144;
  const float* cst = (const float*)smem_raw;
  const int cr = tid >> 4, c0 = (tid & 15) * 8;
  const int ncol0 = n0 + c0;
  if (kind == 1) {
    float bias[8]; ld8(p.b_ff1 + l * 4096 + ncol0, bias);
#pragma unroll 2
    for (int it = 0; it < 8; ++it) {
      const int rl = it * 16 + cr, row = m0 + rowmap256(rl, ps);
      float v[8]; ld8(cst + rl * CS + c0, v);
#pragma unroll
      for (int e = 0; e < 8; ++e) { const float t = fmaxf(v[e] + bias[e], 0.f); v[e] = t * t; }
      *(uint4*)(U + blkA(row, ncol0, 128)) = pack8f(v);
    }
  } else {
    float g[8], bias[8];
    ld8(MOD + mod_idx(m0) * 6144 + (kind == 0 ? 2048 : 5120) + ncol0, g);
    if (kind == 2) ld8(p.b_ff2 + l * 1024 + ncol0, bias);
    else {
#pragma unroll
      for (int e = 0; e < 8; ++e) bias[e] = 0.f;
    }
#pragma unroll 2
    for (int it = 0; it < 8; ++it) {
      const int rl = it * 16 + cr, row = m0 + rowmap256(rl, ps);
      float v[8], xo[8]; ld8(cst + rl * CS + c0, v);
      ld8(((kind == 0 && l == 0) ? xrow_in(p, row) : X + (size_t)row * 1024) + ncol0, xo);
#pragma unroll
      for (int e = 0; e < 8; ++e) xo[e] += g[e] * (v[e] + bias[e]);
      st8(X + (size_t)row * 1024 + ncol0, xo);
    }
  }
}
__device__ void phase_gemm_res(const Params& p, int l, int kind, char* smem_raw) {
  const bf16_t* HB = (const bf16_t*)(p.ws + OFF_HB);
  const bf16_t* U = (const bf16_t*)(p.ws + OFF_PROJ);
  const int NT = kind == 1 ? 32 : 8;
  const bf16_t* A = kind == 2 ? U : HB;
  const int lda = kind == 2 ? 4096 : 1024;
  const int K = kind == 2 ? 4096 : 1024;
  const bf16_t* WT = (const bf16_t*)(p.ws + (kind == 0 ? OFF_WT_OUT : kind == 1 ? OFF_WT_FF1 : OFF_WT_FF2));
  GEMM256_TILE_LOOP(NT) {
    const int m0 = mt * 256, n0 = nt * 128;
    f32x16 acc[4][2];
#pragma unroll
    for (int i = 0; i < 4; ++i) { acc[i][0] = zero16(); acc[i][1] = zero16(); }
    gemm_mainloop256(A, lda, WT, K, K, m0, n0, acc, smem_raw);
    stage_acc256<0>(acc, smem_raw);
    res_epilogue(p, l, kind, m0, n0, 0, smem_raw);
    stage_acc256<1>(acc, smem_raw);
    res_epilogue(p, l, kind, m0, n0, 1, smem_raw);
  }
}

#define XB_TMO      128
#define XB_XCNT(j)  (256  + 64 * (j))
#define XB_XSUB(j)  (1280 + 64 * (j))
#define XB_XGEN(j)  (2304 + 64 * (j))
#define XB_TOP      3328
#define XB_TOPGEN   3392
#define XCD_BAR_WORDS 3456
#define XB_SPIN_CAP (1u << 20)
DI unsigned xb_ld(unsigned* p)              { return __hip_atomic_load(p, __ATOMIC_RELAXED, __HIP_MEMORY_SCOPE_AGENT); }
DI unsigned xb_add(unsigned* p, unsigned v) { return __hip_atomic_fetch_add(p, v, __ATOMIC_RELAXED, __HIP_MEMORY_SCOPE_AGENT); }
#define XB_SPIN(cond, bar) do { unsigned _sp = 0; while (cond) { __builtin_amdgcn_s_sleep(1); \
    if ((++_sp & 255u) == 0u) { if (xb_ld(&(bar)[XB_TMO])) break; if (_sp > XB_SPIN_CAP) { atomicAdd(&(bar)[XB_TMO], 1u); break; } } } } while (0)
DI void xcd_barrier_complete(unsigned* bar, unsigned x, unsigned& nloc, unsigned& nx) {
  const unsigned G = gridDim.x;
  unsigned sum, cnt, mine, sp = 0u;
  for (;;) {
    sum = 0u; cnt = 0u; mine = 0u;
#pragma unroll
    for (unsigned j = 0; j < 16; ++j) { const unsigned c = xb_ld(&bar[XB_XCNT(j)]); sum += c; cnt += (c > 0u) ? 1u : 0u; mine = (j == x) ? c : mine; }
    if (sum == G) break;
    __builtin_amdgcn_s_sleep(1);
    if ((++sp & 255u) == 0u) { if (xb_ld(&bar[XB_TMO])) break; if (sp > XB_SPIN_CAP) { atomicAdd(&bar[XB_TMO], 1u); break; } }
  }
  nloc = mine > 0u ? mine : 1u; nx = cnt > 0u ? cnt : 1u;
}
DI void xcd_barrier(unsigned* bar, unsigned x, uint4& stw) {
  asm volatile("s_waitcnt vmcnt(0)" ::: "memory");
  __syncthreads();
  if (threadIdx.x == 0) {
    __builtin_amdgcn_s_waitcnt(0);
    unsigned nloc = stw.x, nx = stw.y;
    if (nloc == 0u) { xcd_barrier_complete(bar, x, nloc, nx); stw.x = nloc; stw.y = nx; }
    const unsigned old = xb_add(&bar[XB_XSUB(x)], 1u);
    const unsigned gen = old / nloc;
    if (old + 1u == (gen + 1u) * nloc) {
      __builtin_amdgcn_fence(__ATOMIC_RELEASE, "agent");
      asm volatile("s_waitcnt vmcnt(0)" ::: "memory");
      const unsigned og = xb_add(&bar[XB_TOP], 1u);
      const unsigned tg = og / nx;
      if (og + 1u == (tg + 1u) * nx) xb_add(&bar[XB_TOPGEN], 1u);
      else XB_SPIN(xb_ld(&bar[XB_TOPGEN]) == tg, bar);
      __builtin_amdgcn_fence(__ATOMIC_ACQUIRE, "agent");
      xb_add(&bar[XB_XGEN(x)], 1u);
      asm volatile("s_waitcnt vmcnt(0)" ::: "memory");
    } else {
      XB_SPIN(xb_ld(&bar[XB_XGEN(x)]) == gen, bar);
      __builtin_amdgcn_fence(__ATOMIC_ACQUIRE, "agent");
      asm volatile("s_waitcnt vmcnt(0)" ::: "memory");
    }
  }
  __syncthreads();
}

__global__ void __launch_bounds__(256, 2) mega(Params p, int phase_lo, int phase_hi) {
  __shared__ __attribute__((aligned(16))) char smem_raw[SMEM_BYTES];
  __shared__ int s_item;
  __shared__ uint4 xb_words;
  unsigned* bar = (unsigned*)(p.ws + OFF_BAR);
  const unsigned xcc = xb_xcc_id();
  if (phase_hi - phase_lo > 1) {
    if (threadIdx.x == 0) { xb_words = make_uint4(0u, 0u, 0u, 0u); (void)xb_add(&bar[XB_XCNT(xcc)], 1u); }
    __syncthreads();
  }
  for (int ph = phase_lo; ph < phase_hi; ++ph) {
    if (ph > phase_lo) {
      if (phase_lo < 0) cg::this_grid().sync();
      xcd_barrier(bar, xcc, xb_words);
    }
    if (ph == 0) { phase_setup(p, smem_raw); phase_norm_conv(p, 0, smem_raw, 1); continue; }
    if (ph == NPHASE - 1) { phase_norm_only(p, 0, 2); continue; }
    const int l = (ph - 1) / 11, s = (ph - 1) % 11;
#ifndef REPMASK
#define REPMASK 0
#endif
    for (int rep = 0; rep < (((REPMASK >> s) & 1) ? 2 : 1); ++rep) {
    if (rep > 0) xcd_barrier(bar, xcc, xb_words);
    switch (s) {
      case 0: phase_norm_conv(p, l, smem_raw, l == 0 ? 2 : 0); break;
      case 1: phase_inproj(p, l, smem_raw); break;
      case 2: phase_mixers(p, l + 4 * rep, smem_raw, &s_item); break;
      case 3: phase_lat_scan(p, l); break;
      case 4: phase_lat_c(p, l, smem_raw); break;
      case 5: phase_mlpost(p, l); break;
      case 6: phase_upproj(p, l, smem_raw); break;
      case 7: phase_gemm_res(p, l, 0, smem_raw); break;
      case 8: phase_norm_only(p, l, 1); break;
      case 9: phase_gemm_res(p, l, 1, smem_raw); break;
      default: phase_gemm_res(p, l, 2, smem_raw); break;
    }
    }
  }
}

extern "C" void kernel_launch(void* const* d_in, const int* in_sizes, int n_in, void* d_out, int out_size,
                              void* d_ws, size_t ws_size, hipStream_t stream) {
  (void)in_sizes; (void)n_in; (void)out_size;
  if (ws_size < WS_NEEDED) { fprintf(stderr, "workspace too small: %zu < %llu\n", ws_size, (unsigned long long)WS_NEEDED); return; }
  Params p{};
  const float** f = (const float**)&p;
  for (int i = 0; i < 30; ++i) f[i] = (const float*)d_in[i];
  p.out = (float*)d_out;
  p.ws = (char*)d_ws;
  static int grid = 0;
  if (!grid) {
    int dev = 0, cus = 0, per_cu = 0;
    hipGetDevice(&dev);
    hipDeviceGetAttribute(&cus, hipDeviceAttributeMultiprocessorCount, dev);
    hipOccupancyMaxActiveBlocksPerMultiprocessor(&per_cu, mega, 256, 0);
    if (per_cu > 2) per_cu = 2;
    grid = (cus * per_cu) & ~7;
    if (grid < 8) grid = 8;
  }
#if MK_ONE_LAUNCH
  hipMemsetAsync((char*)d_ws + OFF_BAR, 0, XCD_BAR_WORDS * 4, stream);
  int lo = 0, hi = NPHASE;
  void* args[] = {&p, &lo, &hi};
  hipError_t e = hipLaunchCooperativeKernel((void*)mega, dim3(grid), dim3(256), args, 0, stream);
  if (e != hipSuccess) fprintf(stderr, "cooperative launch failed: %s (grid %d)\n", hipGetErrorString(e), grid);
#else
  for (int ph = 0; ph < NPHASE; ++ph) hipLaunchKernelGGL(mega, dim3(grid), dim3(256), 0, stream, p, ph, ph + 1);
#endif
}
```
